# Optimizing an MI355X kernel written in HIP

```python
import math
import jax, jax.numpy as jnp
from jax import lax
import numpy as np

D_MODEL = 1024
BATCH = 2
SEQ = 8192
DEPTH = 2
DEC_BATCH = 32
DEC_SEQ = 8
PAST_LEN = 16384
PAGE_SIZE = 128

N_A_LAYERS = DEPTH // 2
N_B_LAYERS = DEPTH - N_A_LAYERS
D_FF = 2816
SSM_GROUP = 16
N_SSM_GROUPS = D_MODEL // SSM_GROUP
SSM_STATE = 64
HEAD_DIM = 64
WINDOWS = (128, 512, 2048)
DILATIONS = (1, 4, 16)
N_BRANCHES = 3
HEADS_PER_BRANCH = 8
N_HEADS = N_BRANCHES * HEADS_PER_BRANCH
ATTN_WIDTH = N_HEADS * HEAD_DIM
MERGED_WIDTH = HEADS_PER_BRANCH * HEAD_DIM
MAX_WINDOW = max(WINDOWS)
ROT_DIM = HEAD_DIM // 4
ROPE_THETA = 500000.0
Q_BLOCK = 128
RMS_EPS = 1e-6
NEG_INF = -1e30

kernel_name = "yoco_s5_dilated_swa_decoder_step"


def _rms(x, g):
    x32 = x.astype(jnp.float32)
    y = x32 * lax.rsqrt(jnp.mean(x32 * x32, axis=-1, keepdims=True) + RMS_EPS) * g.astype(jnp.float32)
    return y.astype(x.dtype)


def _swiglu(h, w_in, w_out):
    g, u = jnp.split(h @ w_in, 2, axis=-1)
    return (jax.nn.silu(g) * u) @ w_out


def _rope_partial(x, pos):
    half = ROT_DIM // 2
    inv = ROPE_THETA ** (-jnp.arange(0, ROT_DIM, 2, dtype=jnp.float32) / ROT_DIM)
    ang = pos.astype(jnp.float32)[:, None] * inv[None, :]
    cos = jnp.cos(ang)[None, :, None, :]
    sin = jnp.sin(ang)[None, :, None, :]
    x32 = x.astype(jnp.float32)
    x1 = x32[..., :half]
    x2 = x32[..., half:ROT_DIM]
    out = jnp.concatenate([x1 * cos - x2 * sin, x2 * cos + x1 * sin, x32[..., ROT_DIM:]], axis=-1)
    return out.astype(x.dtype)


def _lin_combine(e1, e2):
    a1, b1 = e1
    a2, b2 = e2
    return a1 * a2, a2 * b1 + b2


def _s5_mixer(u, h0, a_re, a_im, log_dt, b_re, b_im, c_re, c_im, d_skip, w_glu):
    bsz, seq_len, _ = u.shape
    f32 = jnp.float32
    lam = lax.complex(a_re.astype(f32), a_im.astype(f32))
    dt = jnp.exp(log_dt.astype(f32))[:, None]
    lam_bar = jnp.exp(lam * dt)
    b_bar = ((lam_bar - 1.0) / lam)[:, :, None] * lax.complex(b_re.astype(f32), b_im.astype(f32))
    c = lax.complex(c_re.astype(f32), c_im.astype(f32))
    ug = u.astype(f32).reshape(bsz, seq_len, N_SSM_GROUPS, SSM_GROUP)
    bu = jnp.einsum('blgh,gph->blgp', ug.astype(jnp.complex64), b_bar)
    h0c = lax.complex(h0[..., 0].astype(f32), h0[..., 1].astype(f32))
    bu = bu.at[:, 0].add(lam_bar * h0c)
    a = jnp.broadcast_to(lam_bar, bu.shape)
    _, h = lax.associative_scan(_lin_combine, (a, bu), axis=1)
    y = jnp.real(jnp.einsum('blgp,ghp->blgh', h, c)) + d_skip.astype(f32).reshape(N_SSM_GROUPS, SSM_GROUP) * ug
    z = jax.nn.gelu(y.reshape(bsz, seq_len, D_MODEL)).astype(u.dtype)
    za, zb = jnp.split(z @ w_glu, 2, axis=-1)
    out = za * jax.nn.sigmoid(zb)
    h_last = h[:, -1]
    new_state = jnp.stack([jnp.real(h_last), jnp.imag(h_last)], axis=-1).astype(h0.dtype)
    return out, new_state


def _branch_attend(q_b, loc_b, k_br, v_br, dilation, n_taps):
    idx = loc_b[:, None] - dilation * jnp.arange(n_taps, dtype=jnp.int32)[None, :]
    valid = idx >= 0
    idx = jnp.maximum(idx, 0)
    kg = jnp.take(k_br, idx, axis=1)
    vg = jnp.take(v_br, idx, axis=1)
    s = jnp.einsum('bqhd,bqthd->bhqt', q_b.astype(jnp.float32), kg.astype(jnp.float32)) * (HEAD_DIM ** -0.5)
    s = jnp.where(valid[None, None], s, NEG_INF)
    lse = jax.nn.logsumexp(s, axis=-1)
    p = jnp.exp(s - lse[..., None])
    o = jnp.einsum('bhqt,bqthd->bqhd', p, vg.astype(jnp.float32))
    return o, lse


def _dilated_block(q_b, loc_b, k_brs, v_brs):
    outs, lses = [], []
    for i in range(N_BRANCHES):
        hs = slice(i * HEADS_PER_BRANCH, (i + 1) * HEADS_PER_BRANCH)
        o, lse = _branch_attend(q_b[:, :, hs], loc_b, k_brs[i], v_brs[i], DILATIONS[i], WINDOWS[i] // DILATIONS[i] + 1)
        outs.append(o)
        lses.append(lse)
    w = jax.nn.softmax(jnp.stack(lses, axis=0), axis=0)
    w = jnp.transpose(w, (0, 1, 3, 2))[..., None]
    return jnp.sum(w * jnp.stack(outs, axis=0), axis=0)


def _dilated_attention(q, k_src, v_src, q_loc):
    bsz, nq = q.shape[0], q.shape[1]
    k_brs = [k_src[:, :, i * HEADS_PER_BRANCH:(i + 1) * HEADS_PER_BRANCH] for i in range(N_BRANCHES)]
    v_brs = [v_src[:, :, i * HEADS_PER_BRANCH:(i + 1) * HEADS_PER_BRANCH] for i in range(N_BRANCHES)]
    if nq > Q_BLOCK:
        nb = nq // Q_BLOCK
        qb = q.reshape(bsz, nb, Q_BLOCK, N_HEADS, HEAD_DIM).transpose(1, 0, 2, 3, 4)
        lb = q_loc.reshape(nb, Q_BLOCK)
        ob = lax.map(lambda a: _dilated_block(a[0], a[1], k_brs, v_brs), (qb, lb))
        o = ob.transpose(1, 0, 2, 3, 4).reshape(bsz, nq, HEADS_PER_BRANCH, HEAD_DIM)
    else:
        o = _dilated_block(q, q_loc, k_brs, v_brs)
    return o.reshape(bsz, nq, MERGED_WIDTH)


def _trunk(x, pos, ssm_h0, past_k, past_v,
           ffn_norm1, ffn_w1_in, ffn_w1_out, ffn_norm2, ffn_w2_in, ffn_w2_out, mix_norm,
           ssm_a_re, ssm_a_im, ssm_log_dt, ssm_b_re, ssm_b_im, ssm_c_re, ssm_c_im, ssm_d, ssm_w_glu,
           kv_norm, w_kv, w_q, w_o, final_norm):
    bsz, nq = x.shape[0], x.shape[1]
    new_ssm = []
    k_src = v_src = q_loc = None
    for layer in range(DEPTH):
        x = x + 0.5 * _swiglu(_rms(x, ffn_norm1[layer]), ffn_w1_in[layer], ffn_w1_out[layer])
        h = _rms(x, mix_norm[layer])
        if layer < N_A_LAYERS:
            out, st = _s5_mixer(h, ssm_h0[layer], ssm_a_re[layer], ssm_a_im[layer], ssm_log_dt[layer],
                                ssm_b_re[layer], ssm_b_im[layer], ssm_c_re[layer], ssm_c_im[layer],
                                ssm_d[layer], ssm_w_glu[layer])
            new_ssm.append(st)
            x = x + out
        else:
            j = layer - N_A_LAYERS
            q = _rope_partial((h @ w_q[j]).reshape(bsz, nq, N_HEADS, HEAD_DIM), pos)
            o = _dilated_attention(q, k_src, v_src, q_loc)
            x = x + o.astype(x.dtype) @ w_o[j]
        x = x + 0.5 * _swiglu(_rms(x, ffn_norm2[layer]), ffn_w2_in[layer], ffn_w2_out[layer])
        if layer == N_A_LAYERS - 1:
            hk = _rms(x, kv_norm)
            k_new, v_new = jnp.split(hk @ w_kv, 2, axis=-1)
            k_new = _rope_partial(k_new.reshape(bsz, nq, N_HEADS, HEAD_DIM), pos)
            v_new = v_new.reshape(bsz, nq, N_HEADS, HEAD_DIM)
            k_src = jnp.concatenate([past_k.astype(k_new.dtype), k_new], axis=1)
            v_src = jnp.concatenate([past_v.astype(v_new.dtype), v_new], axis=1)
            q_loc = past_k.shape[1] + jnp.arange(nq, dtype=jnp.int32)
    keep = min(MAX_WINDOW, k_src.shape[1])
    return _rms(x, final_norm), jnp.stack(new_ssm, axis=0), k_src[:, -keep:], v_src[:, -keep:]


def setup_inputs(seed: int = 0) -> dict:
    key = jax.random.key(seed)
    ks = jax.random.split(key, 32)
    f32 = jnp.float32
    nrm = lambda k, shape, scale: jax.random.normal(k, shape, f32) * scale
    buf = min(MAX_WINDOW, PAST_LEN)
    G, P, H = N_SSM_GROUPS, SSM_STATE, SSM_GROUP
    a_im0 = math.pi * jnp.arange(P, dtype=f32)
    return {
        "x_prompt": nrm(ks[0], (BATCH, SEQ, D_MODEL), 1.0),
        "x_sample": nrm(ks[1], (DEC_BATCH, DEC_SEQ, D_MODEL), 1.0),
        "state_ssm": nrm(ks[2], (N_A_LAYERS, DEC_BATCH, G, P, 2), 0.3),
        "cache_k": nrm(ks[3], (DEC_BATCH, buf, N_HEADS, HEAD_DIM), 1.0),
        "cache_v": nrm(ks[4], (DEC_BATCH, buf, N_HEADS, HEAD_DIM), 1.0),
        "ffn_norm1": 1.0 + nrm(ks[5], (DEPTH, D_MODEL), 0.02),
        "ffn_w1_in": nrm(ks[6], (DEPTH, D_MODEL, 2 * D_FF), D_MODEL ** -0.5),
        "ffn_w1_out": nrm(ks[7], (DEPTH, D_FF, D_MODEL), D_FF ** -0.5),
        "ffn_norm2": 1.0 + nrm(ks[8], (DEPTH, D_MODEL), 0.02),
        "ffn_w2_in": nrm(ks[9], (DEPTH, D_MODEL, 2 * D_FF), D_MODEL ** -0.5),
        "ffn_w2_out": nrm(ks[10], (DEPTH, D_FF, D_MODEL), D_FF ** -0.5),
        "mix_norm": 1.0 + nrm(ks[11], (DEPTH, D_MODEL), 0.02),
        "ssm_a_re": -0.5 + nrm(ks[12], (N_A_LAYERS, G, P), 0.01),
        "ssm_a_im": a_im0 + nrm(ks[13], (N_A_LAYERS, G, P), 0.01),
        "ssm_log_dt": jax.random.uniform(ks[14], (N_A_LAYERS, G), f32, math.log(1e-3), math.log(1e-1)),
        "ssm_b_re": nrm(ks[15], (N_A_LAYERS, G, P, H), (2 * H) ** -0.5),
        "ssm_b_im": nrm(ks[16], (N_A_LAYERS, G, P, H), (2 * H) ** -0.5),
        "ssm_c_re": nrm(ks[17], (N_A_LAYERS, G, H, P), P ** -0.5),
        "ssm_c_im": nrm(ks[18], (N_A_LAYERS, G, H, P), P ** -0.5),
        "ssm_d": nrm(ks[19], (N_A_LAYERS, D_MODEL), 1.0),
        "ssm_w_glu": nrm(ks[20], (N_A_LAYERS, D_MODEL, 2 * D_MODEL), D_MODEL ** -0.5),
        "kv_norm": 1.0 + nrm(ks[21], (D_MODEL,), 0.02),
        "w_kv": nrm(ks[22], (D_MODEL, 2 * ATTN_WIDTH), D_MODEL ** -0.5),
        "w_q": nrm(ks[23], (N_B_LAYERS, D_MODEL, ATTN_WIDTH), D_MODEL ** -0.5),
        "w_o": nrm(ks[24], (N_B_LAYERS, MERGED_WIDTH, D_MODEL), MERGED_WIDTH ** -0.5),
        "final_norm": 1.0 + nrm(ks[25], (D_MODEL,), 0.02),
    }


def reference(x_prompt, x_sample, state_ssm, cache_k, cache_v,
              ffn_norm1, ffn_w1_in, ffn_w1_out, ffn_norm2, ffn_w2_in, ffn_w2_out, mix_norm,
              ssm_a_re, ssm_a_im, ssm_log_dt, ssm_b_re, ssm_b_im, ssm_c_re, ssm_c_im, ssm_d, ssm_w_glu,
              kv_norm, w_kv, w_q, w_o, final_norm):
    bp, sp = x_prompt.shape[0], x_prompt.shape[1]
    bs, ss = x_sample.shape[0], x_sample.shape[1]
    pos_p = jnp.arange(sp, dtype=jnp.int32)
    h0_p = jnp.zeros((N_A_LAYERS, bp, N_SSM_GROUPS, SSM_STATE, 2), x_prompt.dtype)
    past_p = jnp.zeros((bp, 0, N_HEADS, HEAD_DIM), x_prompt.dtype)
    y_prompt, state_ssm_prompt, cache_k_prompt, cache_v_prompt = _trunk(
        x_prompt, pos_p, h0_p, past_p, past_p,
        ffn_norm1, ffn_w1_in, ffn_w1_out, ffn_norm2, ffn_w2_in, ffn_w2_out, mix_norm,
        ssm_a_re, ssm_a_im, ssm_log_dt, ssm_b_re, ssm_b_im, ssm_c_re, ssm_c_im, ssm_d, ssm_w_glu,
        kv_norm, w_kv, w_q, w_o, final_norm)
    pos_s = PAST_LEN + jnp.arange(ss, dtype=jnp.int32)
    y_sample, state_ssm_sample, cache_k_sample, cache_v_sample = _trunk(
        x_sample, pos_s, state_ssm, cache_k, cache_v,
        ffn_norm1, ffn_w1_in, ffn_w1_out, ffn_norm2, ffn_w2_in, ffn_w2_out, mix_norm,
        ssm_a_re, ssm_a_im, ssm_log_dt, ssm_b_re, ssm_b_im, ssm_c_re, ssm_c_im, ssm_d, ssm_w_glu,
        kv_norm, w_kv, w_q, w_o, final_norm)
    return (y_prompt, y_sample, state_ssm_prompt, cache_k_prompt, cache_v_prompt,
            state_ssm_sample, cache_k_sample, cache_v_sample)
```

```cpp
#include <hip/hip_runtime.h>
#include <hip/hip_cooperative_groups.h>
#include <cstdio>
#include <cstdint>
namespace cg = cooperative_groups;
namespace pg8 {
#define PG8_LAS __attribute__((address_space(3)))
typedef unsigned short bf16_t;
typedef short bf16x8 __attribute__((ext_vector_type(8)));
typedef float f32x4 __attribute__((ext_vector_type(4)));
typedef unsigned u32x4 __attribute__((ext_vector_type(4)));
constexpr int BM = 256, BK = 64, HALF = 128, HTB = HALF * BK * 2  , STAGE_BYTES = 8 * HTB, NXCD = 8, WGM = 8;

__host__ __device__ __forceinline__ int lds_byte(int r, int c) { const int st = (r >> 4) * 2 + (c >> 5), rr = r & 15, cc = c & 31, ob = rr * 64 + cc * 2; return st * 1024 + (ob ^ (((ob >> 9) & 1) << 5)); }
__host__ __device__ __forceinline__ void stage_rc(int b, int& R, int& C) { const int st = b / 1024, sb = b % 1024, swz = sb ^ (((sb >> 9) & 1) << 5); R = (st >> 1) * 16 + swz / 64; C = (st & 1) * 32 + (swz % 64) / 2; }
__host__ __device__ __forceinline__ int perm32(int rho) { const int n = rho >> 4, i = rho & 15; return 8 * (i >> 2) + 4 * n + (i & 3); }

struct Unit { int pm, pn; };
struct Gemm { const bf16_t* A; const bf16_t* Bt; int M, N, K; };

struct StaticOrder {
    int nM, nN, nwg, G, c;
    __host__ __device__ void init(int M, int N, int G_, int c_) { nM = M / BM; nN = N / BM; nwg = nM * nN; G = G_; c = c_; }
    __host__ __device__ bool next(int i, Unit& u) const {
        const long L = (long)i * G + c; if (L >= nwg) return false;
        int wgid = (int)L; { const int q = nwg / NXCD, r = nwg % NXCD, xcd = wgid % NXCD, off = wgid / NXCD; wgid = (xcd < r ? xcd * (q + 1) : r * (q + 1) + (xcd - r) * q) + off; }
        const int nig = WGM * nN, gid = wgid / nig, fm = gid * WGM, gsz = (nM - fm) < WGM ? (nM - fm) : WGM;
        u.pm = fm + ((wgid % nig) % gsz); u.pn = (wgid % nig) / gsz; return true;
    }
    __device__ __forceinline__ void a_ready(const Unit&) const {}
    __device__ __forceinline__ void done(const Unit&) const {}
};
__device__ __forceinline__ unsigned cvt_pk_bf16(float lo, float hi) { unsigned r; asm volatile("v_cvt_pk_bf16_f32 %0, %1, %2" : "=v"(r) : "v"(lo), "v"(hi)); return r; }
template <class Epi, class Sched, bool STAMP = false>
__device__ __forceinline__ void gemm_phase(PG8_LAS unsigned char* lds, const Gemm g, const Sched& S, const Epi& E, unsigned long long* stamps) {
    const int tid = threadIdx.x, wid = __builtin_amdgcn_readfirstlane(tid >> 6), lane = tid & 63, wr = wid >> 2, wc = wid & 3, fr = lane & 15, fq = lane >> 4;
    const int K = g.K, nt = K / BK;
    int ts_lo = 0, ts_hi = 0, nts = 0; const unsigned long long rt_entry = STAMP ? (unsigned long long)wall_clock64() : 0ull;
#define PG8_STAMP() do { if (STAMP && wid == 0 && nts < 64) { const unsigned long long _c = (unsigned long long)clock64(); \
        ts_lo = (lane == nts) ? (int)(unsigned)_c : ts_lo; ts_hi = (lane == nts) ? (int)(unsigned)(_c >> 32) : ts_hi; ++nts; } } while (0)
    PG8_STAMP();
    unsigned voffA[2], voffB[2];
#pragma unroll
    for (int i = 0; i < 2; ++i) { int R, C; stage_rc(tid * 16 + i * 8192, R, C); const int Rb = Epi::PERM ? ((R & ~31) + perm32(R & 31)) : R;
        voffA[i] = (unsigned)(R * K + C) * 2u; voffB[i] = (unsigned)(Rb * K + C) * 2u; }
    const size_t kstep = (size_t)(BK * 2);
    const size_t hstep = (size_t)HALF * K * 2;
    const size_t tstep = 2 * hstep;
    const unsigned ldsw = (unsigned)wid * 1024u;
    const int aoff = lds_byte(wr * 64 + fr, fq * 8), boff = lds_byte(wc * 32 + fr, fq * 8);
#define PG8_SA(b, h) (((b) * 2 + (h)) * HTB)
#define PG8_SB(b, h) ((4 + (b) * 2 + (h)) * HTB)
#define PG8_STAGE(bufoff, gbase, voff) do { _Pragma("unroll") for (int _i = 0; _i < 2; ++_i) \
        __builtin_amdgcn_global_load_lds((const unsigned*)((const char*)(gbase) + (voff)[_i]), (PG8_LAS unsigned*)(lds + (bufoff) + ldsw + _i * 8192), 16, 0, 0); } while (0)
#define PG8_LDA(dst, b, h) do { _Pragma("unroll") for (int m = 0; m < 4; ++m) _Pragma("unroll") for (int k = 0; k < 2; ++k) dst[m][k] = *(const PG8_LAS bf16x8*)(lds + PG8_SA(b, h) + aoff + m * 2048 + k * 1024); } while (0)
#define PG8_LDB(dst, b, h) do { _Pragma("unroll") for (int n = 0; n < 2; ++n) _Pragma("unroll") for (int k = 0; k < 2; ++k) dst[n][k] = *(const PG8_LAS bf16x8*)(lds + PG8_SB(b, h) + boff + n * 2048 + k * 1024); } while (0)
#define PG8_MMA(ai, bj, At, Bt) do { __builtin_amdgcn_s_setprio(1); _Pragma("unroll") for (int m = 0; m < 4; ++m) _Pragma("unroll") for (int n = 0; n < 2; ++n) _Pragma("unroll") for (int k = 0; k < 2; ++k) \
        acc[ai][bj][m][n] = __builtin_amdgcn_mfma_f32_16x16x32_bf16(Bt[n][k], At[m][k], acc[ai][bj][m][n], 0, 0, 0); __builtin_amdgcn_s_setprio(0); } while (0)
#define PG8_WAIT_V(n) asm volatile("s_waitcnt vmcnt(" #n ")" ::: "memory")
#define PG8_WAIT_L(n) asm volatile("s_waitcnt lgkmcnt(" #n ")" ::: "memory")
#define PG8_BAR __builtin_amdgcn_s_barrier()
#define PG8_SCHED __builtin_amdgcn_sched_barrier(0)
    Unit cur, nxt; int ui = 0;
    if (!S.next(0, cur)) return;
    f32x4 acc[2][2][4][2];
#pragma unroll
    for (int a = 0; a < 2; ++a)
#pragma unroll
        for (int b = 0; b < 2; ++b)
#pragma unroll
            for (int m = 0; m < 4; ++m)
#pragma unroll
                for (int n = 0; n < 2; ++n) acc[a][b][m][n] = (f32x4){0.f, 0.f, 0.f, 0.f};
    bf16x8 At[4][2], B0[2][2], B1[2][2];
    const char* cA = (const char*)g.A + (size_t)cur.pm * tstep; const char* cB = (const char*)g.Bt + (size_t)cur.pn * tstep;
    S.a_ready(cur);
    PG8_STAGE(PG8_SB(0, 0), cB, voffB); PG8_STAGE(PG8_SA(0, 0), cA, voffA); PG8_STAGE(PG8_SB(0, 1), cB + hstep, voffB); PG8_STAGE(PG8_SA(0, 1), cA + hstep, voffA);
    if (wr == 1) PG8_BAR;
    PG8_WAIT_V(4); PG8_BAR;
    PG8_STAGE(PG8_SB(1, 0), cB + kstep, voffB); PG8_STAGE(PG8_SA(1, 0), cA + kstep, voffA); PG8_STAGE(PG8_SB(1, 1), cB + hstep + kstep, voffB);
    PG8_WAIT_V(6); PG8_BAR;
    PG8_STAMP();
    for (;;) {
        const bool has_next = S.next(ui + 1, nxt);
        const char* nA = has_next ? (const char*)g.A + (size_t)nxt.pm * tstep : cA; const char* nB = has_next ? (const char*)g.Bt + (size_t)nxt.pn * tstep : cB;
        for (int t = 0; t < nt; t += 2) {
            const bool last = (t == nt - 2);
            const char* a1 = cA + (size_t)(t + 1) * kstep;
            const char* a2 = last ? nA : cA + (size_t)(t + 2) * kstep; const char* b2 = last ? nB : cB + (size_t)(t + 2) * kstep;
            const char* a3 = a2 + kstep; const char* b3 = b2 + kstep;
            if (last && has_next) S.a_ready(nxt);
            PG8_LDB(B0, 0, 0); PG8_SCHED; PG8_LDA(At, 0, 0); PG8_STAGE(PG8_SA(1, 1), a1 + hstep, voffA);
            PG8_WAIT_L(8); PG8_BAR; PG8_WAIT_L(0); PG8_MMA(0, 0, At, B0); PG8_BAR; PG8_SCHED;
            PG8_LDB(B1, 0, 1); PG8_STAGE(PG8_SB(0, 0), b2, voffB);
            PG8_BAR; PG8_WAIT_L(0); PG8_MMA(0, 1, At, B1); PG8_BAR;
            PG8_LDA(At, 0, 1); PG8_STAGE(PG8_SA(0, 0), a2, voffA);
            PG8_BAR; PG8_WAIT_L(0); PG8_MMA(1, 0, At, B0); PG8_BAR; PG8_SCHED;
            PG8_STAGE(PG8_SB(0, 1), b2 + hstep, voffB);
            PG8_WAIT_V(6); PG8_BAR; PG8_MMA(1, 1, At, B1); PG8_BAR;
            PG8_LDB(B0, 1, 0); PG8_SCHED; PG8_LDA(At, 1, 0); PG8_STAGE(PG8_SA(0, 1), a2 + hstep, voffA);
            PG8_WAIT_L(8); PG8_BAR; PG8_WAIT_L(0); PG8_MMA(0, 0, At, B0); PG8_BAR; PG8_SCHED;
            PG8_LDB(B1, 1, 1); PG8_STAGE(PG8_SB(1, 0), b3, voffB);
            PG8_BAR; PG8_WAIT_L(0); PG8_MMA(0, 1, At, B1); PG8_BAR;
            PG8_LDA(At, 1, 1); PG8_STAGE(PG8_SA(1, 0), a3, voffA);
            PG8_BAR; PG8_WAIT_L(0); PG8_MMA(1, 0, At, B0); PG8_BAR; PG8_SCHED;
            PG8_STAGE(PG8_SB(1, 1), b3 + hstep, voffB);
            PG8_WAIT_V(6); PG8_BAR; PG8_MMA(1, 1, At, B1); PG8_BAR;
        }
        PG8_STAMP();
        if constexpr (!Epi::AFTER_DRAIN) { E(acc, cur, wr, wc, fr, fq); S.done(cur); }
        PG8_STAMP();
        if (!has_next) break;
#pragma unroll
        for (int a = 0; a < 2; ++a)
#pragma unroll
            for (int b = 0; b < 2; ++b)
#pragma unroll
                for (int m = 0; m < 4; ++m)
#pragma unroll
                    for (int n = 0; n < 2; ++n) acc[a][b][m][n] = (f32x4){0.f, 0.f, 0.f, 0.f};
        cur = nxt; cA = nA; cB = nB; ++ui;
    }
    PG8_WAIT_V(0);
    if (wr == 0) PG8_BAR;
    PG8_BAR;
    if constexpr (Epi::AFTER_DRAIN) { E.fused(acc, cur, wr, wc, fr, fq, lds, wid, lane); S.done(cur); }
    PG8_STAMP();
    if (STAMP && wid == 0) { stamps[lane] = lane < nts ? (((unsigned long long)(unsigned)ts_hi << 32) | (unsigned)ts_lo) : 0ull;
        if (lane == 62) stamps[62] = rt_entry; if (lane == 63) stamps[63] = (unsigned long long)wall_clock64(); }
#undef PG8_STAMP
#undef PG8_SA
#undef PG8_SB
#undef PG8_STAGE
#undef PG8_LDA
#undef PG8_LDB
#undef PG8_MMA
#undef PG8_WAIT_V
#undef PG8_WAIT_L
#undef PG8_BAR
#undef PG8_SCHED
}
}

#define LAS __attribute__((address_space(3)))
using pg8::bf16_t; using pg8::bf16x8; using pg8::f32x4; using pg8::u32x4; using pg8::cvt_pk_bf16;
typedef unsigned u32x2 __attribute__((ext_vector_type(2)));

constexpr int DM = 1024, T_P = 16384, T_S = 256, MT = T_P + T_S, FF = 2816, NH = 24, AW = 1536, MW = 512;
constexpr int SROWS = 2176;
constexpr float RMS_EPS = 1e-6f;
constexpr int NTHREADS = 512, NWAVES = 8;
constexpr int LDS_BYTES = 131072;

constexpr size_t O_YP = 0, O_YS = 16777216, O_SSP = O_YS + 262144, O_CKP = O_SSP + 16384, O_CVP = O_CKP + 6291456,
                 O_SSS = O_CVP + 6291456, O_CKS = O_SSS + 262144, O_CVS = O_CKS + 100663296, O_END = O_CVS + 100663296;

constexpr size_t al256(size_t x) { return (x + 255) & ~(size_t)255; }
constexpr size_t W_IN_B = (size_t)2 * FF * DM * 2, W_OUT_B = (size_t)DM * FF * 2;
constexpr size_t WS_W1IN = 0;
constexpr size_t WS_W2IN = WS_W1IN + 2 * W_IN_B;
constexpr size_t WS_W1OUT = WS_W2IN + 2 * W_IN_B;
constexpr size_t WS_W2OUT = WS_W1OUT + 2 * W_OUT_B;
constexpr size_t WS_WGLU = WS_W2OUT + 2 * W_OUT_B;
constexpr size_t WS_WKV = WS_WGLU + (size_t)2048 * 1024 * 2;
constexpr size_t WS_WQ = WS_WKV + (size_t)3072 * 1024 * 2;
constexpr size_t WS_WO = WS_WQ + (size_t)1536 * 1024 * 2;
constexpr size_t WS_X = WS_WO + (size_t)1024 * 512 * 2;
constexpr size_t WS_XB = WS_X + (size_t)MT * DM * 4;
constexpr size_t WS_H = WS_XB + (size_t)MT * DM * 2;
constexpr size_t WS_Z = WS_H + (size_t)MT * FF * 2;
constexpr size_t WS_SS = WS_Z + (size_t)MT * DM * 2;
constexpr size_t WS_ROPE = al256(WS_SS + (size_t)7 * MT * 4);
constexpr size_t WS_LAM = WS_ROPE + (size_t)MT * 16 * 4;
constexpr size_t WS_LAM64 = WS_LAM + 4096 * 8;
constexpr size_t WS_BRE = WS_LAM64 + 4096 * 8;
constexpr size_t WS_BIM = WS_BRE + 4096 * 64;
constexpr size_t WS_CPK = WS_BIM + 4096 * 64;
constexpr size_t WS_SLOC = WS_CPK + (size_t)64 * 16 * 128 * 2;
constexpr size_t WS_QP = WS_SLOC + (size_t)2 * 128 * 4096 * 8;
constexpr size_t WS_QS = WS_QP + (size_t)2 * 24 * 8192 * 64 * 2;
constexpr size_t WS_KPP = WS_QS + (size_t)32 * 24 * 8 * 64 * 2;
constexpr size_t WS_VTP = WS_KPP + (size_t)2 * 24 * 8192 * 64 * 2;
constexpr size_t WS_KPS = WS_VTP + (size_t)2 * 24 * 8192 * 64 * 2;
constexpr size_t WS_VTS = WS_KPS + (size_t)32 * 24 * SROWS * 64 * 2;
constexpr size_t WS_OBR = WS_VTS + (size_t)32 * 24 * SROWS * 64 * 2;
constexpr size_t WS_LSE = WS_OBR + (size_t)MT * AW * 4;
constexpr size_t WS_OB = al256(WS_LSE + (size_t)MT * 24 * 4);
constexpr size_t WS_END = WS_OB + (size_t)MT * MW * 2;

struct Params {
    const float *x_prompt, *x_sample, *state_ssm, *cache_k, *cache_v;
    const float *ffn_norm1, *ffn_w1_in, *ffn_w1_out, *ffn_norm2, *ffn_w2_in, *ffn_w2_out, *mix_norm;
    const float *a_re, *a_im, *log_dt, *b_re, *b_im, *c_re, *c_im, *ssm_d, *w_glu;
    const float *kv_norm, *w_kv, *w_q, *w_o, *final_norm;
    float* out;
    unsigned char* ws;
};

__device__ __forceinline__ float wave_sum(float v) {
#pragma unroll
    for (int o = 1; o < 64; o <<= 1) v += __shfl_xor(v, o);
    return v;
}
__device__ __forceinline__ bf16_t f2bf(float f) { return (bf16_t)(cvt_pk_bf16(f, 0.f) & 0xffffu); }
__device__ __forceinline__ float rs_of(float ss) { return rsqrtf(ss * (1.0f / DM) + RMS_EPS); }
#define LDS_FENCE() asm volatile("s_waitcnt lgkmcnt(0)" ::: "memory")

__device__ __forceinline__ void dsincos(double a, double& s, double& c) {
    const double k = rint(a * 0.63661977236758134308);
    double r = fma(-k, 1.5707963267948966, a); r = fma(-k, 6.123233995736766e-17, r);
    const int q = (int)(((long long)k) & 3);
    const double r2 = r * r;
    const double sr = r * (1.0 + r2 * (-1.0 / 6 + r2 * (1.0 / 120 + r2 * (-1.0 / 5040 + r2 * (1.0 / 362880 + r2 * (-1.0 / 39916800 + r2 * (1.0 / 6227020800.0 + r2 * (-1.0 / 1307674368000.0))))))));
    const double cr = 1.0 + r2 * (-0.5 + r2 * (1.0 / 24 + r2 * (-1.0 / 720 + r2 * (1.0 / 40320 + r2 * (-1.0 / 3628800 + r2 * (1.0 / 479001600.0 + r2 * (-1.0 / 87178291200.0 + r2 * (1.0 / 20922789888000.0))))))));
    s = (q == 0) ? sr : (q == 1) ? cr : (q == 2) ? -sr : -cr;
    c = (q == 0) ? cr : (q == 1) ? -sr : (q == 2) ? -cr : sr;
}

__device__ __forceinline__ void tok_info(int row, int& is_s, int& b, int& pos) {
    if (row < T_P) { is_s = 0; b = row >> 13; pos = row & 8191; } else { const int rr = row - T_P; is_s = 1; b = rr >> 3; pos = 2048 + (rr & 7); }
}

__device__ __forceinline__ void wt_item(const float* W, int K, int N, bf16_t* WT, const float* gain, int Nh, LAS float* scr, int item, int lane) {
    const int nblk = N / 32, kb = item / nblk, nb = item % nblk, k0 = 64 * kb, n0 = 32 * nb;
    const int c0 = Nh ? (((n0 >> 7) & 1) * Nh + (n0 >> 8) * 128 + (n0 & 127)) : n0;
#pragma unroll 8
    for (int i = 0; i < 32; ++i) { const int kk = 2 * i + (lane >> 5); float v = W[(size_t)(k0 + kk) * N + c0 + (lane & 31)]; if (gain) v *= gain[k0 + kk]; scr[kk * 33 + (lane & 31)] = v; }
    LDS_FENCE();
    const int c = lane & 7;
#pragma unroll
    for (int j = 0; j < 4; ++j) { const int n = (lane >> 3) + 8 * j; const LAS float* s = scr + (8 * c) * 33 + n;
        u32x4 o; o.x = cvt_pk_bf16(s[0 * 33], s[1 * 33]); o.y = cvt_pk_bf16(s[2 * 33], s[3 * 33]); o.z = cvt_pk_bf16(s[4 * 33], s[5 * 33]); o.w = cvt_pk_bf16(s[6 * 33], s[7 * 33]);
        *(u32x4*)(WT + (size_t)(n0 + n) * K + k0 + 8 * c) = o; }
    LDS_FENCE();
}

__device__ __forceinline__ void phase0(const Params& p, LAS unsigned char* lds) {
    const int tid = threadIdx.x, lane = tid & 63, wave = tid >> 6;
    const int gw = blockIdx.x * NWAVES + wave, NGW = gridDim.x * NWAVES;
    const size_t gt = (size_t)blockIdx.x * NTHREADS + tid, NT = (size_t)gridDim.x * NTHREADS;
    unsigned char* ws = p.ws;
    LAS float* scr = (LAS float*)(lds + wave * 8448);
    {
        constexpr int I_IN = (DM / 64) * (2 * FF / 32), I_OUT = (FF / 64) * (DM / 32), I_GLU = (DM / 64) * (2048 / 32), I_KV = (DM / 64) * (3072 / 32), I_Q = (DM / 64) * (1536 / 32), I_O = (512 / 64) * (1024 / 32);
        constexpr int NIT = 4 * I_IN + 4 * I_OUT + I_GLU + I_KV + I_Q + I_O;
        for (int it = gw; it < NIT; it += NGW) {
            int r = it;
            if (r < 4 * I_IN) { const int w = r / I_IN, l = w & 1, which = w >> 1; r -= w * I_IN;
                const float* W = (which ? p.ffn_w2_in : p.ffn_w1_in) + (size_t)l * DM * 2 * FF; const float* g = (which ? p.ffn_norm2 : p.ffn_norm1) + l * DM;
                bf16_t* WT = (bf16_t*)(ws + (which ? WS_W2IN : WS_W1IN) + l * W_IN_B);
                wt_item(W, DM, 2 * FF, WT, g, FF, scr, r, lane); continue; }
            r -= 4 * I_IN;
            if (r < 4 * I_OUT) { const int w = r / I_OUT, l = w & 1, which = w >> 1; r -= w * I_OUT;
                const float* W = (which ? p.ffn_w2_out : p.ffn_w1_out) + (size_t)l * FF * DM;
                bf16_t* WT = (bf16_t*)(ws + (which ? WS_W2OUT : WS_W1OUT) + l * W_OUT_B);
                wt_item(W, FF, DM, WT, nullptr, 0, scr, r, lane); continue; }
            r -= 4 * I_OUT;
            if (r < I_GLU) { wt_item(p.w_glu, DM, 2048, (bf16_t*)(ws + WS_WGLU), nullptr, 1024, scr, r, lane); continue; }
            r -= I_GLU;
            if (r < I_KV) { wt_item(p.w_kv, DM, 3072, (bf16_t*)(ws + WS_WKV), p.kv_norm, 0, scr, r, lane); continue; }
            r -= I_KV;
            if (r < I_Q) { wt_item(p.w_q, DM, 1536, (bf16_t*)(ws + WS_WQ), p.mix_norm + DM, 0, scr, r, lane); continue; }
            r -= I_Q;
            wt_item(p.w_o, 512, 1024, (bf16_t*)(ws + WS_WO), nullptr, 0, scr, r, lane);
        }
    }
    {
        float* X = (float*)(ws + WS_X); bf16_t* Xb = (bf16_t*)(ws + WS_XB); float* ss0 = (float*)(ws + WS_SS);
        for (int row = gw; row < MT; row += NGW) {
            const float* src = row < T_P ? p.x_prompt + (size_t)row * DM : p.x_sample + (size_t)(row - T_P) * DM;
            float s = 0.f;
#pragma unroll
            for (int j = 0; j < 4; ++j) { const f32x4 v = ((const f32x4*)src)[lane + 64 * j]; ((f32x4*)(X + (size_t)row * DM))[lane + 64 * j] = v; s += (v.x * v.x + v.y * v.y) + (v.z * v.z + v.w * v.w);
                u32x2 o; o.x = cvt_pk_bf16(v.x, v.y); o.y = cvt_pk_bf16(v.z, v.w); ((u32x2*)(Xb + (size_t)row * DM))[lane + 64 * j] = o; }
            s = wave_sum(s); if (lane == 0) ss0[row] = s;
        }
    }
    { float* ss = (float*)(ws + WS_SS) + MT; for (size_t i = gt; i < (size_t)6 * MT; i += NT) ss[i] = 0.f; }
    {
        float* rope = (float*)(ws + WS_ROPE);
        for (size_t i = gt; i < (size_t)MT * 8; i += NT) { const int row = (int)(i >> 3), k = (int)(i & 7);
            const int posq = row < T_P ? (row & 8191) : 16384 + ((row - T_P) & 7);
            const double inv = exp(-(double)(2 * k) / 16.0 * 13.122363377404328);
            double s, c; dsincos((double)posq * inv, s, c); rope[i * 2] = (float)c; rope[i * 2 + 1] = (float)s; }
    }
    {
        float* LAM = (float*)(ws + WS_LAM); float* LAM64 = (float*)(ws + WS_LAM64); float* BRE = (float*)(ws + WS_BRE); float* BIM = (float*)(ws + WS_BIM); bf16_t* CPK = (bf16_t*)(ws + WS_CPK);
        for (size_t i = gt; i < 4096; i += NT) { const int g = (int)(i >> 6), pp = (int)(i & 63);
            const double dt = exp((double)p.log_dt[g]), are = p.a_re[i], aim = p.a_im[i];
            double s, c; dsincos(aim * dt, s, c); const double mag = exp(are * dt), lr = mag * c, li = mag * s;
            LAM[2 * i] = (float)lr; LAM[2 * i + 1] = (float)li;
            dsincos(64.0 * aim * dt, s, c); const double m64 = exp(64.0 * are * dt); LAM64[2 * i] = (float)(m64 * c); LAM64[2 * i + 1] = (float)(m64 * s);
            const double den = are * are + aim * aim, nr = lr - 1.0, ni = li;
            const double cr = (nr * are + ni * aim) / den, ci = (ni * are - nr * aim) / den;
#pragma unroll
            for (int h = 0; h < 16; ++h) { const double br = p.b_re[i * 16 + h], bi = p.b_im[i * 16 + h];
                BRE[i * 16 + h] = (float)(cr * br - ci * bi); BIM[i * 16 + h] = (float)(cr * bi + ci * br);
                CPK[((size_t)g * 16 + h) * 128 + pp] = f2bf(p.c_re[((size_t)g * 16 + h) * 64 + pp]); CPK[((size_t)g * 16 + h) * 128 + 64 + pp] = f2bf(-p.c_im[((size_t)g * 16 + h) * 64 + pp]); }
        }
    }
    {
        bf16_t* KPS = (bf16_t*)(ws + WS_KPS);
        const size_t n = (size_t)32 * 2048 * 24 * 8;
        for (size_t i = gt; i < n; i += NT) { const int ch = (int)(i & 7), head = (int)((i >> 3) % 24); const size_t bp = (i >> 3) / 24; const int pos = (int)(bp & 2047), b = (int)(bp >> 11);
            const int br = head >> 3, sh = 2 * br;
            const bool need = br == 0 ? pos >= 1920 : br == 1 ? pos >= 1536 : (pos & 15) < 8;
            if (!need) continue;
            const int r = pos & ((1 << sh) - 1), m = pos >> sh, Lr = (2048 >> sh) + 8;
            const float* src = p.cache_k + (((size_t)b * 2048 + pos) * 24 + head) * 64 + ch * 8;
            const f32x4 a = *(const f32x4*)src, c = *(const f32x4*)(src + 4);
            u32x4 o; o.x = cvt_pk_bf16(a.x, a.y); o.y = cvt_pk_bf16(a.z, a.w); o.z = cvt_pk_bf16(c.x, c.y); o.w = cvt_pk_bf16(c.z, c.w);
            *(u32x4*)(KPS + (((size_t)b * 24 + head) * SROWS + r * Lr + m) * 64 + ch * 8) = o; }
    }
    {
        bf16_t* VTS = (bf16_t*)(ws + WS_VTS);
        LAS bf16_t* T = (LAS bf16_t*)scr;
        for (int it = gw; it < 32 * 208; it += NGW) { const int b = it / 208, rem = it % 208; int head, sub, r, m0;
            if (rem < 16) { head = rem >> 1; sub = rem & 1; r = 0; m0 = 1920 + 64 * sub; }
            else if (rem < 80) { const int x = rem - 16; head = 8 + (x >> 3); sub = x & 7; r = sub >> 1; m0 = 384 + 64 * (sub & 1); }
            else { const int x = rem - 80; head = 16 + (x >> 4); sub = x & 15; r = sub >> 1; m0 = 64 * (sub & 1); }
            const int sh = 2 * (head >> 3), Lr = (2048 >> sh) + 8;
#pragma unroll 8
            for (int mm = 0; mm < 64; ++mm) { const int pos = ((m0 + mm) << sh) + r; T[lane * 66 + mm] = f2bf(p.cache_v[(((size_t)b * 2048 + pos) * 24 + head) * 64 + lane]); }
            LDS_FENCE();
            bf16_t* dst = VTS + ((size_t)b * 24 + head) * (64 * SROWS) + (size_t)r * 64 * Lr + m0;
#pragma unroll
            for (int j = 0; j < 8; ++j) { const int dd = 8 * j + (lane >> 3), ch = lane & 7; const LAS unsigned* s = (const LAS unsigned*)(T + dd * 66 + 8 * ch);
                u32x4 o; o.x = s[0]; o.y = s[1]; o.z = s[2]; o.w = s[3]; *(u32x4*)(dst + (size_t)dd * Lr + 8 * ch) = o; }
            LDS_FENCE();
        }
    }
    {
        constexpr size_t PER_B = (size_t)2040 * 1536 / 4, TOT = 2 * 32 * PER_B;
        for (size_t i = gt; i < TOT; i += NT) { const int kv = (int)(i / (32 * PER_B)); const size_t rem = i % (32 * PER_B); const size_t b = rem / PER_B, e = rem % PER_B;
            const f32x4* src = (const f32x4*)((kv ? p.cache_v : p.cache_k) + b * ((size_t)2048 * 1536) + (size_t)8 * 1536) + e;
            f32x4* dst = (f32x4*)(p.out + (kv ? O_CVS : O_CKS) + b * ((size_t)2048 * 1536)) + e;
            __builtin_nontemporal_store(__builtin_nontemporal_load(src), dst); }
    }
}

struct EpiSwiGLU {
    static constexpr bool PERM = true, AFTER_DRAIN = false;
    bf16_t* H; const float* ss;
    __device__ __forceinline__ void operator()(const f32x4 (&acc)[2][2][4][2], const pg8::Unit& u, int wr, int wc, int fr, int fq) const {
        const int row0 = u.pm * 256 + wr * 64 + fr, col0 = u.pn * 128 + wc * 32 + 8 * fq;
#pragma unroll
        for (int ai = 0; ai < 2; ++ai)
#pragma unroll
            for (int m = 0; m < 4; ++m) { const int row = row0 + ai * 128 + m * 16; const float rs = rs_of(ss[row]);
                float h[8];
#pragma unroll
                for (int n = 0; n < 2; ++n)
#pragma unroll
                    for (int j = 0; j < 4; ++j) { const float g = acc[ai][0][m][n][j] * rs, uu = acc[ai][1][m][n][j] * rs; h[4 * n + j] = g * __builtin_amdgcn_rcpf(1.f + __expf(-g)) * uu; }
                u32x4 w; w.x = cvt_pk_bf16(h[0], h[1]); w.y = cvt_pk_bf16(h[2], h[3]); w.z = cvt_pk_bf16(h[4], h[5]); w.w = cvt_pk_bf16(h[6], h[7]);
                *(u32x4*)(H + (size_t)row * FF + col0) = w; }
    }
};
struct EpiResid {
    static constexpr bool PERM = true, AFTER_DRAIN = false;
    float* X; bf16_t* Xb; float* ss_out; float scale;
    __device__ __forceinline__ void operator()(const f32x4 (&acc)[2][2][4][2], const pg8::Unit& u, int wr, int wc, int fr, int fq) const {
        const int row0 = u.pm * 256 + wr * 64 + fr;
#pragma unroll
        for (int ai = 0; ai < 2; ++ai)
#pragma unroll
            for (int m = 0; m < 4; ++m) { const int row = row0 + ai * 128 + m * 16; float sq = 0.f;
#pragma unroll
                for (int bj = 0; bj < 2; ++bj) { const int col = u.pn * 256 + bj * 128 + wc * 32 + 8 * fq; float* xp = X + (size_t)row * DM + col;
                    f32x4 a = *(const f32x4*)xp, b = *(const f32x4*)(xp + 4); a += acc[ai][bj][m][0] * scale; b += acc[ai][bj][m][1] * scale;
                    *(f32x4*)xp = a; *(f32x4*)(xp + 4) = b; sq += (a.x * a.x + a.y * a.y) + (a.z * a.z + a.w * a.w) + (b.x * b.x + b.y * b.y) + (b.z * b.z + b.w * b.w);
                    u32x4 w; w.x = cvt_pk_bf16(a.x, a.y); w.y = cvt_pk_bf16(a.z, a.w); w.z = cvt_pk_bf16(b.x, b.y); w.w = cvt_pk_bf16(b.z, b.w);
                    *(u32x4*)(Xb + (size_t)row * DM + col) = w; }
                sq += __shfl_xor(sq, 16); sq += __shfl_xor(sq, 32);
                if (fq == 0) unsafeAtomicAdd(ss_out + row, sq); }
    }
};
struct EpiGLU {
    static constexpr bool PERM = true, AFTER_DRAIN = false;
    float* X; bf16_t* Xb; float* ss_out;
    __device__ __forceinline__ void operator()(const f32x4 (&acc)[2][2][4][2], const pg8::Unit& u, int wr, int wc, int fr, int fq) const {
        const int row0 = u.pm * 256 + wr * 64 + fr, col = u.pn * 128 + wc * 32 + 8 * fq;
#pragma unroll
        for (int ai = 0; ai < 2; ++ai)
#pragma unroll
            for (int m = 0; m < 4; ++m) { const int row = row0 + ai * 128 + m * 16; float* xp = X + (size_t)row * DM + col;
                f32x4 a = *(const f32x4*)xp, b = *(const f32x4*)(xp + 4);
#pragma unroll
                for (int j = 0; j < 4; ++j) { a[j] += acc[ai][0][m][0][j] * __builtin_amdgcn_rcpf(1.f + __expf(-acc[ai][1][m][0][j])); b[j] += acc[ai][0][m][1][j] * __builtin_amdgcn_rcpf(1.f + __expf(-acc[ai][1][m][1][j])); }
                *(f32x4*)xp = a; *(f32x4*)(xp + 4) = b;
                float sq = (a.x * a.x + a.y * a.y) + (a.z * a.z + a.w * a.w) + (b.x * b.x + b.y * b.y) + (b.z * b.z + b.w * b.w);
                u32x4 w; w.x = cvt_pk_bf16(a.x, a.y); w.y = cvt_pk_bf16(a.z, a.w); w.z = cvt_pk_bf16(b.x, b.y); w.w = cvt_pk_bf16(b.z, b.w);
                *(u32x4*)(Xb + (size_t)row * DM + col) = w;
                sq += __shfl_xor(sq, 16); sq += __shfl_xor(sq, 32);
                if (fq == 0) unsafeAtomicAdd(ss_out + row, sq); }
    }
};
__device__ __forceinline__ void rope8(f32x4& v0, f32x4& v1, const float* cs, bool rot_wave, int fq) {
    if (rot_wave) {
        const f32x4 c01 = *(const f32x4*)cs, c23 = *(const f32x4*)(cs + 4), c45 = *(const f32x4*)(cs + 8), c67 = *(const f32x4*)(cs + 12);
        const float cc[8] = {c01.x, c01.z, c23.x, c23.z, c45.x, c45.z, c67.x, c67.z}, sn[8] = {c01.y, c01.w, c23.y, c23.w, c45.y, c45.w, c67.y, c67.w};
#pragma unroll
        for (int j = 0; j < 4; ++j) {
            const float p0 = __shfl_xor(v0[j], 16), p1 = __shfl_xor(v1[j], 16);
            const float a0 = fq == 0 ? v0[j] * cc[j] - p0 * sn[j] : v0[j] * cc[j] + p0 * sn[j];
            const float a1 = fq == 0 ? v1[j] * cc[4 + j] - p1 * sn[4 + j] : v1[j] * cc[4 + j] + p1 * sn[4 + j];
            if (fq < 2) { v0[j] = a0; v1[j] = a1; }
        }
    }
}
struct EpiKV {
    static constexpr bool PERM = true, AFTER_DRAIN = false;
    const float* ss; const float* rope; float* out; bf16_t *KPP, *VTP, *KPS, *VTS;
    __device__ __forceinline__ void operator()(const f32x4 (&acc)[2][2][4][2], const pg8::Unit& u, int wr, int wc, int fr, int fq) const {
        const int row0 = u.pm * 256 + wr * 64 + fr; const bool isv = u.pn >= 6; const int pn6 = isv ? u.pn - 6 : u.pn;
        const int dim0 = 32 * (wc & 1) + 8 * fq; const bool rot_wave = !isv && (wc & 1) == 0;
#pragma unroll
        for (int ai = 0; ai < 2; ++ai)
#pragma unroll
            for (int m = 0; m < 4; ++m) { const int row = row0 + ai * 128 + m * 16; const float rs = rs_of(ss[row]);
                int is_s, b, pos; tok_info(row, is_s, b, pos);
#pragma unroll
                for (int bj = 0; bj < 2; ++bj) { const int head = pn6 * 4 + 2 * bj + (wc >> 1), sh = 2 * (head >> 3);
                    f32x4 v0 = acc[ai][bj][m][0] * rs, v1 = acc[ai][bj][m][1] * rs;
                    rope8(v0, v1, rope + (size_t)row * 16, rot_wave, fq);
                    if (is_s) { float* o = out + (isv ? O_CVS : O_CKS) + (((size_t)b * 2048 + (pos - 8)) * 24 + head) * 64 + dim0; *(f32x4*)o = v0; *(f32x4*)(o + 4) = v1; }
                    else if (pos >= 6144) { float* o = out + (isv ? O_CVP : O_CKP) + (((size_t)b * 2048 + (pos - 6144)) * 24 + head) * 64 + dim0; *(f32x4*)o = v0; *(f32x4*)(o + 4) = v1; }
                    const int r = pos & ((1 << sh) - 1), mm = pos >> sh, Lr = is_s ? (2048 >> sh) + 8 : (8192 >> sh);
                    if (!isv) { u32x4 w; w.x = cvt_pk_bf16(v0.x, v0.y); w.y = cvt_pk_bf16(v0.z, v0.w); w.z = cvt_pk_bf16(v1.x, v1.y); w.w = cvt_pk_bf16(v1.z, v1.w);
                        bf16_t* kb = is_s ? KPS + ((size_t)b * 24 + head) * SROWS * 64 : KPP + ((size_t)b * 24 + head) * 8192 * 64;
                        *(u32x4*)(kb + ((size_t)r * Lr + mm) * 64 + dim0) = w; }
                    else { bf16_t* vb = (is_s ? VTS + ((size_t)b * 24 + head) * (64 * SROWS) : VTP + ((size_t)b * 24 + head) * (64 * 8192)) + ((size_t)r * 64 + dim0) * Lr + mm;
#pragma unroll
                        for (int j = 0; j < 4; ++j) { vb[(size_t)j * Lr] = f2bf(v0[j]); vb[(size_t)(4 + j) * Lr] = f2bf(v1[j]); } }
                }
            }
    }
};
struct EpiQ {
    static constexpr bool PERM = true, AFTER_DRAIN = false;
    const float* ss; const float* rope; bf16_t *QP, *QS;
    __device__ __forceinline__ void operator()(const f32x4 (&acc)[2][2][4][2], const pg8::Unit& u, int wr, int wc, int fr, int fq) const {
        const int row0 = u.pm * 256 + wr * 64 + fr; const int dim0 = 32 * (wc & 1) + 8 * fq; const bool rot_wave = (wc & 1) == 0;
#pragma unroll
        for (int ai = 0; ai < 2; ++ai)
#pragma unroll
            for (int m = 0; m < 4; ++m) { const int row = row0 + ai * 128 + m * 16; const float rs = rs_of(ss[row]);
                int is_s, b, pos; tok_info(row, is_s, b, pos);
#pragma unroll
                for (int bj = 0; bj < 2; ++bj) { const int head = u.pn * 4 + 2 * bj + (wc >> 1), sh = 2 * (head >> 3);
                    f32x4 v0 = acc[ai][bj][m][0] * rs, v1 = acc[ai][bj][m][1] * rs;
                    rope8(v0, v1, rope + (size_t)row * 16, rot_wave, fq);
                    v0 *= 0.125f; v1 *= 0.125f;
                    u32x4 w; w.x = cvt_pk_bf16(v0.x, v0.y); w.y = cvt_pk_bf16(v0.z, v0.w); w.z = cvt_pk_bf16(v1.x, v1.y); w.w = cvt_pk_bf16(v1.z, v1.w);
                    const int r = pos & ((1 << sh) - 1), mm = pos >> sh;
                    if (is_s) { const int j = pos - 2048; const int qidx = sh == 0 ? j : sh == 2 ? (j & 3) * 2 + (j >> 2) : j;
                        *(u32x4*)(QS + (((size_t)b * 24 + head) * 8 + qidx) * 64 + dim0) = w; }
                    else *(u32x4*)(QP + (((size_t)b * 24 + head) * 8192 + (size_t)r * (8192 >> sh) + mm) * 64 + dim0) = w;
                }
            }
    }
};

template <class Epi>
__device__ __forceinline__ void run_gemm(LAS unsigned char* lds, const bf16_t* A, const bf16_t* Bt, int N, int K, const Epi& E) {
    pg8::Gemm g; g.A = A; g.Bt = Bt; g.M = MT; g.N = N; g.K = K;
    pg8::StaticOrder S; S.init(MT, N, (int)gridDim.x, (int)blockIdx.x);
    pg8::gemm_phase<Epi, pg8::StaticOrder, false>(lds, g, S, E, nullptr);
}

template <bool FULL>
__device__ __forceinline__ void s5_pass(const Params& p, LAS unsigned char* lds) {
    const int tid = threadIdx.x, lane = tid & 63, wave = tid >> 6, fr = lane & 15, fq = lane >> 4;
    unsigned char* ws = p.ws;
    const float* X = (const float*)(ws + WS_X); const float* ss1 = (const float*)(ws + WS_SS) + MT;
    const float* LAM = (const float*)(ws + WS_LAM); const float* LAM64 = (const float*)(ws + WS_LAM64); const float* BRE = (const float*)(ws + WS_BRE); const float* BIM = (const float*)(ws + WS_BIM);
    const bf16_t* CPK = (const bf16_t*)(ws + WS_CPK); float* SLOC = (float*)(ws + WS_SLOC); bf16_t* Z = (bf16_t*)(ws + WS_Z);
    LAS float* U = (LAS float*)lds;
    LAS bf16_t* Hs = (LAS bf16_t*)(lds + 32768) + wave * (16 * 136);
    const int nitems = FULL ? 2304 : 2048;
    for (int it = blockIdx.x; it < nitems; it += gridDim.x) {
        int is_s, b, c, go, tok0, nt;
        if (it < 2048) { is_s = 0; b = it >> 10; c = (it >> 3) & 127; go = it & 7; tok0 = b * 8192 + c * 64; nt = 64; }
        else { const int x = it - 2048; is_s = 1; b = x >> 3; go = x & 7; c = 0; tok0 = T_P + b * 8; nt = 8; }
        for (int i = tid; i < nt * 32; i += NTHREADS) { const int t = i >> 5, c4 = i & 31, row = tok0 + t; const float rs = rs_of(ss1[row]);
            f32x4 v = *(const f32x4*)(X + (size_t)row * DM + go * 128 + c4 * 4); const f32x4 gg = *(const f32x4*)(p.mix_norm + go * 128 + c4 * 4);
            v = v * rs * gg; *(LAS f32x4*)(U + t * 128 + c4 * 4) = v; }
        __syncthreads();
        const int g = go * 8 + wave, gp = g * 64 + lane;
        float Bre[16], Bim[16];
#pragma unroll
        for (int q = 0; q < 4; ++q) { const f32x4 a = *(const f32x4*)(BRE + (size_t)gp * 16 + 4 * q), bb = *(const f32x4*)(BIM + (size_t)gp * 16 + 4 * q);
#pragma unroll
            for (int j = 0; j < 4; ++j) { Bre[4 * q + j] = a[j]; Bim[4 * q + j] = bb[j]; } }
        const float lr = LAM[2 * gp], li = LAM[2 * gp + 1];
        float hre = 0.f, him = 0.f;
        bf16x8 cf[4]; float dsk = 0.f;
        if (FULL) {
            if (is_s) { const float* s0 = p.state_ssm + ((size_t)b * 4096 + gp) * 2; hre = s0[0]; him = s0[1]; }
            else { const float l6r = LAM64[2 * gp], l6i = LAM64[2 * gp + 1];
                for (int j = 0; j < c; ++j) { const float* s = SLOC + (((size_t)b * 128 + j) * 4096 + gp) * 2; const float sr = s[0], si = s[1];
                    const float nr = l6r * hre - l6i * him + sr; him = l6r * him + l6i * hre + si; hre = nr; } }
#pragma unroll
            for (int kk = 0; kk < 4; ++kk) cf[kk] = *(const bf16x8*)(CPK + ((size_t)g * 16 + fr) * 128 + 32 * kk + 8 * fq);
            dsk = p.ssm_d[16 * g + fr];
        }
        for (int t0 = 0; t0 < nt; t0 += 16) {
#pragma unroll 4
            for (int tt = 0; tt < 16; ++tt) {
                if (t0 + tt < nt) {
                    const LAS float* ur = U + (t0 + tt) * 128 + 16 * wave;
                    float bre = 0.f, bim = 0.f;
#pragma unroll
                    for (int q = 0; q < 4; ++q) { const f32x4 uv = *(const LAS f32x4*)(ur + 4 * q);
#pragma unroll
                        for (int j = 0; j < 4; ++j) { bre = fmaf(Bre[4 * q + j], uv[j], bre); bim = fmaf(Bim[4 * q + j], uv[j], bim); } }
                    const float nr = lr * hre - li * him + bre; him = lr * him + li * hre + bim; hre = nr;
                }
                if (FULL) { Hs[tt * 136 + lane] = f2bf(hre); Hs[tt * 136 + 64 + lane] = f2bf(him); }
            }
            if (FULL) {
                LDS_FENCE();
                f32x4 y = {0.f, 0.f, 0.f, 0.f};
#pragma unroll
                for (int kk = 0; kk < 4; ++kk) { const bf16x8 af = *(const LAS bf16x8*)(Hs + fr * 136 + 32 * kk + 8 * fq); y = __builtin_amdgcn_mfma_f32_16x16x32_bf16(af, cf[kk], y, 0, 0, 0); }
#pragma unroll
                for (int e = 0; e < 4; ++e) { const int t = t0 + 4 * fq + e;
                    if (t < nt) { const float yy = y[e] + dsk * U[t * 128 + 16 * wave + fr];
                        const float a = 0.7978845608028654f * (yy + 0.044715f * yy * yy * yy); const float th = 1.f - 2.f * __builtin_amdgcn_rcpf(__expf(2.f * a) + 1.f);
                        Z[(size_t)(tok0 + t) * DM + 16 * g + fr] = f2bf(0.5f * yy * (1.f + th)); } }
                LDS_FENCE();
            }
        }
        if (FULL) {
            if (is_s) { float* o = p.out + O_SSS + ((size_t)b * 4096 + gp) * 2; o[0] = hre; o[1] = him; }
            else if (c == 127) { float* o = p.out + O_SSP + ((size_t)b * 4096 + gp) * 2; o[0] = hre; o[1] = him; }
        } else { float* s = SLOC + (((size_t)b * 128 + c) * 4096 + gp) * 2; s[0] = hre; s[1] = him; }
        __syncthreads();
    }
}

__device__ __forceinline__ void attn_phase(const Params& p) {
    const int tid = threadIdx.x, lane = tid & 63, wave = tid >> 6, fr = lane & 15, fq = lane >> 4;
    const int gw = blockIdx.x * NWAVES + wave, NGW = gridDim.x * NWAVES;
    unsigned char* ws = p.ws;
    const bf16_t *QP = (const bf16_t*)(ws + WS_QP), *QS = (const bf16_t*)(ws + WS_QS), *KPP = (const bf16_t*)(ws + WS_KPP), *VTP = (const bf16_t*)(ws + WS_VTP), *KPS = (const bf16_t*)(ws + WS_KPS), *VTS = (const bf16_t*)(ws + WS_VTS);
    float* OBR = (float*)(ws + WS_OBR); float* LSE = (float*)(ws + WS_LSE);
    constexpr int NP = 2 * 24 * 512, NS = 32 * 104;
    for (int item = gw; item < NP + NS; item += NGW) {
        int is_s, b, head, r, mq0, nqv;
        if (item < NP) { is_s = 0; b = item / 12288; const int rem = item % 12288; head = rem >> 9; const int wt = rem & 511; const int sh = 2 * (head >> 3), per = 512 >> sh; r = wt / per; mq0 = 16 * (wt % per); nqv = 16; }
        else { const int si = item - NP; is_s = 1; b = si / 104; const int rem = si % 104;
            if (rem < 8) { head = rem; r = 0; mq0 = 2048; nqv = 8; }
            else if (rem < 40) { const int x = rem - 8; head = 8 + (x >> 2); r = x & 3; mq0 = 512; nqv = 2; }
            else { const int x = rem - 40; head = 16 + (x >> 3); r = x & 7; mq0 = 128; nqv = 1; } }
        const int sh = 2 * (head >> 3);
        const int Lr = is_s ? (2048 >> sh) + 8 : (8192 >> sh);
        const bf16_t* Kb = (is_s ? KPS + ((size_t)b * 24 + head) * SROWS * 64 : KPP + ((size_t)b * 24 + head) * 8192 * 64) + (size_t)r * Lr * 64;
        const bf16_t* Vb = (is_s ? VTS + ((size_t)b * 24 + head) * (64 * SROWS) : VTP + ((size_t)b * 24 + head) * (64 * 8192)) + (size_t)r * 64 * Lr;
        const int qi = fr < nqv ? fr : nqv - 1;
        const bf16_t* Qrow = is_s ? QS + (((size_t)b * 24 + head) * 8 + r * nqv + qi) * 64 : QP + (((size_t)b * 24 + head) * 8192 + (size_t)r * Lr + mq0 + qi) * 64;
        const bf16x8 q0 = *(const bf16x8*)(Qrow + 8 * fq), q1 = *(const bf16x8*)(Qrow + 32 + 8 * fq);
        const int mk0 = mq0 - 128;
        f32x4 s[9];
#pragma unroll
        for (int blk = 0; blk < 9; ++blk) { int mj = mk0 + 16 * blk + fr; mj = mj < 0 ? 0 : (mj > Lr - 1 ? Lr - 1 : mj);
            const bf16_t* kr = Kb + (size_t)mj * 64 + 8 * fq; const bf16x8 k0 = *(const bf16x8*)kr, k1 = *(const bf16x8*)(kr + 32);
            f32x4 a = {0.f, 0.f, 0.f, 0.f}; a = __builtin_amdgcn_mfma_f32_16x16x32_bf16(k0, q0, a, 0, 0, 0); s[blk] = __builtin_amdgcn_mfma_f32_16x16x32_bf16(k1, q1, a, 0, 0, 0); }
        float mx = -3.0e38f;
#pragma unroll
        for (int blk = 0; blk < 9; ++blk)
#pragma unroll
            for (int e = 0; e < 4; ++e) { const int j = 16 * blk + 4 * fq + e; const bool ok = (j >= fr) && (j <= fr + 128) && (mk0 + j >= 0);
                const float v = ok ? s[blk][e] : -1.0e30f; s[blk][e] = v; mx = fmaxf(mx, v); }
        mx = fmaxf(mx, __shfl_xor(mx, 16)); mx = fmaxf(mx, __shfl_xor(mx, 32));
        float l = 0.f;
#pragma unroll
        for (int blk = 0; blk < 9; ++blk)
#pragma unroll
            for (int e = 0; e < 4; ++e) { const float pe = __expf(s[blk][e] - mx); l += pe; s[blk][e] = pe; }
        l += __shfl_xor(l, 16); l += __shfl_xor(l, 32);
        f32x4 o[4];
#pragma unroll
        for (int db = 0; db < 4; ++db) o[db] = (f32x4){0.f, 0.f, 0.f, 0.f};
#pragma unroll
        for (int pr = 0; pr < 5; ++pr) {
            u32x4 pw; pw.x = cvt_pk_bf16(s[2 * pr][0], s[2 * pr][1]); pw.y = cvt_pk_bf16(s[2 * pr][2], s[2 * pr][3]);
            if (pr < 4) { pw.z = cvt_pk_bf16(s[2 * pr + 1][0], s[2 * pr + 1][1]); pw.w = cvt_pk_bf16(s[2 * pr + 1][2], s[2 * pr + 1][3]); } else { pw.z = 0u; pw.w = 0u; }
            const bf16x8 pf = __builtin_bit_cast(bf16x8, pw);
            int ma = mk0 + 32 * pr + 4 * fq, mb = ma + 16;
            ma = ma < 0 ? 0 : (ma > Lr - 4 ? Lr - 4 : ma); mb = mb < 0 ? 0 : (mb > Lr - 4 ? Lr - 4 : mb);
#pragma unroll
            for (int db = 0; db < 4; ++db) { const bf16_t* vr = Vb + (size_t)(16 * db + fr) * Lr;
                const u32x2 va = *(const u32x2*)(vr + ma), vb = *(const u32x2*)(vr + mb);
                u32x4 vw; vw.x = va.x; vw.y = va.y; vw.z = vb.x; vw.w = vb.y;
                o[db] = __builtin_amdgcn_mfma_f32_16x16x32_bf16(__builtin_bit_cast(bf16x8, vw), pf, o[db], 0, 0, 0); }
        }
        if (fr < nqv) {
            const int pq = ((mq0 + fr) << sh) + r;
            const int token = is_s ? T_P + b * 8 + (pq - 2048) : b * 8192 + pq;
            const float inv = 1.f / l;
#pragma unroll
            for (int db = 0; db < 4; ++db) *(f32x4*)(OBR + (size_t)token * AW + head * 64 + 16 * db + 4 * fq) = o[db] * inv;
            if (fq == 0) LSE[(size_t)token * 24 + head] = mx + logf(l);
        }
    }
}

__device__ __forceinline__ void merge_phase(const Params& p) {
    const size_t gt = (size_t)blockIdx.x * NTHREADS + threadIdx.x, NT = (size_t)gridDim.x * NTHREADS;
    const float* OBR = (const float*)(p.ws + WS_OBR); const float* LSE = (const float*)(p.ws + WS_LSE); bf16_t* OB = (bf16_t*)(p.ws + WS_OB);
    for (size_t i = gt; i < (size_t)MT * 64; i += NT) { const size_t token = i >> 6; const int h = (int)((i >> 3) & 7), ch = (int)(i & 7);
        const float l0 = LSE[token * 24 + h], l1 = LSE[token * 24 + 8 + h], l2 = LSE[token * 24 + 16 + h];
        const float mx = fmaxf(l0, fmaxf(l1, l2)); float w0 = __expf(l0 - mx), w1 = __expf(l1 - mx), w2 = __expf(l2 - mx); const float inv = 1.f / (w0 + w1 + w2); w0 *= inv; w1 *= inv; w2 *= inv;
        const float* o0 = OBR + token * AW + h * 64 + ch * 8;
        const f32x4 a0 = *(const f32x4*)o0, b0 = *(const f32x4*)(o0 + 4), a1 = *(const f32x4*)(o0 + 512), b1 = *(const f32x4*)(o0 + 516), a2 = *(const f32x4*)(o0 + 1024), b2 = *(const f32x4*)(o0 + 1028);
        const f32x4 a = a0 * w0 + a1 * w1 + a2 * w2, bb = b0 * w0 + b1 * w1 + b2 * w2;
        u32x4 w; w.x = cvt_pk_bf16(a.x, a.y); w.y = cvt_pk_bf16(a.z, a.w); w.z = cvt_pk_bf16(bb.x, bb.y); w.w = cvt_pk_bf16(bb.z, bb.w);
        *(u32x4*)(OB + token * MW + h * 64 + ch * 8) = w; }
}

__device__ __forceinline__ void final_phase(const Params& p) {
    const int lane = threadIdx.x & 63, wave = threadIdx.x >> 6;
    const int gw = blockIdx.x * NWAVES + wave, NGW = gridDim.x * NWAVES;
    const float* X = (const float*)(p.ws + WS_X); const float* ss6 = (const float*)(p.ws + WS_SS) + (size_t)6 * MT;
    for (int row = gw; row < MT; row += NGW) { const float rs = rs_of(ss6[row]);
        float* dst = row < T_P ? p.out + O_YP + (size_t)row * DM : p.out + O_YS + (size_t)(row - T_P) * DM;
#pragma unroll
        for (int j = 0; j < 4; ++j) { const f32x4 v = ((const f32x4*)(X + (size_t)row * DM))[lane + 64 * j], g = ((const f32x4*)p.final_norm)[lane + 64 * j]; ((f32x4*)dst)[lane + 64 * j] = v * rs * g; }
    }
}

__global__ void __launch_bounds__(NTHREADS, 2) yoco_fwd(Params p) {
    extern __shared__ __attribute__((aligned(16))) unsigned char shm[];
    LAS unsigned char* lds = (LAS unsigned char*)shm;
    cg::grid_group grid = cg::this_grid();
    unsigned char* ws = p.ws;
    float* X = (float*)(ws + WS_X); bf16_t* Xb = (bf16_t*)(ws + WS_XB); bf16_t* H = (bf16_t*)(ws + WS_H); bf16_t* Z = (bf16_t*)(ws + WS_Z); float* SS = (float*)(ws + WS_SS);
    const float* rope = (const float*)(ws + WS_ROPE);

    phase0(p, lds);
    grid.sync();
    { EpiSwiGLU e; e.H = H; e.ss = SS; run_gemm(lds, Xb, (const bf16_t*)(ws + WS_W1IN), 2 * FF, DM, e); }
    grid.sync();
    { EpiResid e; e.X = X; e.Xb = Xb; e.ss_out = SS + MT; e.scale = 0.5f; run_gemm(lds, H, (const bf16_t*)(ws + WS_W1OUT), DM, FF, e); }
    grid.sync();
    s5_pass<false>(p, lds);
    grid.sync();
    s5_pass<true>(p, lds);
    grid.sync();
    { EpiGLU e; e.X = X; e.Xb = Xb; e.ss_out = SS + 2 * MT; run_gemm(lds, Z, (const bf16_t*)(ws + WS_WGLU), 2048, DM, e); }
    grid.sync();
    { EpiSwiGLU e; e.H = H; e.ss = SS + 2 * MT; run_gemm(lds, Xb, (const bf16_t*)(ws + WS_W2IN), 2 * FF, DM, e); }
    grid.sync();
    { EpiResid e; e.X = X; e.Xb = Xb; e.ss_out = SS + 3 * MT; e.scale = 0.5f; run_gemm(lds, H, (const bf16_t*)(ws + WS_W2OUT), DM, FF, e); }
    grid.sync();
    { EpiKV e; e.ss = SS + 3 * MT; e.rope = rope; e.out = p.out; e.KPP = (bf16_t*)(ws + WS_KPP); e.VTP = (bf16_t*)(ws + WS_VTP); e.KPS = (bf16_t*)(ws + WS_KPS); e.VTS = (bf16_t*)(ws + WS_VTS);
      run_gemm(lds, Xb, (const bf16_t*)(ws + WS_WKV), 3072, DM, e); }
    { EpiSwiGLU e; e.H = H; e.ss = SS + 3 * MT; run_gemm(lds, Xb, (const bf16_t*)(ws + WS_W1IN + W_IN_B), 2 * FF, DM, e); }
    grid.sync();
    { EpiResid e; e.X = X; e.Xb = Xb; e.ss_out = SS + 4 * MT; e.scale = 0.5f; run_gemm(lds, H, (const bf16_t*)(ws + WS_W1OUT + W_OUT_B), DM, FF, e); }
    grid.sync();
    { EpiQ e; e.ss = SS + 4 * MT; e.rope = rope; e.QP = (bf16_t*)(ws + WS_QP); e.QS = (bf16_t*)(ws + WS_QS); run_gemm(lds, Xb, (const bf16_t*)(ws + WS_WQ), 1536, DM, e); }
    grid.sync();
    attn_phase(p);
    grid.sync();
    merge_phase(p);
    grid.sync();
    { EpiResid e; e.X = X; e.Xb = Xb; e.ss_out = SS + 5 * MT; e.scale = 1.0f; run_gemm(lds, (const bf16_t*)(ws + WS_OB), (const bf16_t*)(ws + WS_WO), DM, MW, e); }
    grid.sync();
    { EpiSwiGLU e; e.H = H; e.ss = SS + 5 * MT; run_gemm(lds, Xb, (const bf16_t*)(ws + WS_W2IN + W_IN_B), 2 * FF, DM, e); }
    grid.sync();
    { EpiResid e; e.X = X; e.Xb = Xb; e.ss_out = SS + 6 * MT; e.scale = 0.5f; run_gemm(lds, H, (const bf16_t*)(ws + WS_W2OUT + W_OUT_B), DM, FF, e); }
    grid.sync();
    final_phase(p);
}

extern "C" void kernel_launch(void* const* d_in, const int* in_sizes, int n_in, void* d_out, int out_size, void* d_ws, size_t ws_size, hipStream_t stream) {
    static int grid_blocks = 0;
    if (grid_blocks == 0) {
        if (n_in != 26 || (size_t)out_size != O_END || ws_size < WS_END) { fprintf(stderr, "kernel_launch: unexpected shapes (n_in %d, out %d, ws %zu; need ws >= %zu)\n", n_in, out_size, ws_size, (size_t)WS_END); grid_blocks = -1; return; }
        int dev = 0, cus = 0, per_cu = 0;
        hipGetDevice(&dev);
        hipDeviceGetAttribute(&cus, hipDeviceAttributeMultiprocessorCount, dev);
        if (hipFuncSetAttribute((const void*)yoco_fwd, hipFuncAttributeMaxDynamicSharedMemorySize, LDS_BYTES) != hipSuccess) { fprintf(stderr, "kernel_launch: hipFuncSetAttribute failed\n"); grid_blocks = -1; return; }
        if (hipOccupancyMaxActiveBlocksPerMultiprocessor(&per_cu, (const void*)yoco_fwd, NTHREADS, LDS_BYTES) != hipSuccess || per_cu < 1) { fprintf(stderr, "kernel_launch: occupancy query failed (%d)\n", per_cu); per_cu = 1; (void)hipGetLastError(); }
        if (per_cu > 1) per_cu = 1;
        grid_blocks = cus * per_cu;
    }
    if (grid_blocks < 0) return;
    Params p{};
    const float** f = (const float**)&p;
    for (int i = 0; i < 26; ++i) f[i] = (const float*)d_in[i];
    p.out = (float*)d_out; p.ws = (unsigned char*)d_ws;
    void* args[] = {&p};
    hipError_t e = hipLaunchCooperativeKernel((const void*)yoco_fwd, dim3(grid_blocks), dim3(NTHREADS), args, LDS_BYTES, stream);
    if (e != hipSuccess) fprintf(stderr, "cooperative launch failed: %s (grid %d)\n", hipGetErrorString(e), grid_blocks);
}
```

```cpp
#include <hip/hip_runtime.h>
#include <hip/hip_cooperative_groups.h>
#include <cstdio>
#include <cstdint>
namespace cg = cooperative_groups;
namespace pg8 {
#define PG8_LAS __attribute__((address_space(3)))
typedef unsigned short bf16_t;
typedef short bf16x8 __attribute__((ext_vector_type(8)));
typedef float f32x4 __attribute__((ext_vector_type(4)));
typedef unsigned u32x4 __attribute__((ext_vector_type(4)));
constexpr int BM = 256, BK = 64, HALF = 128, HTB = HALF * BK * 2  , STAGE_BYTES = 8 * HTB, NXCD = 8, WGM = 8;

__host__ __device__ __forceinline__ int lds_byte(int r, int c) { const int st = (r >> 4) * 2 + (c >> 5), rr = r & 15, cc = c & 31, ob = rr * 64 + cc * 2; return st * 1024 + (ob ^ (((ob >> 9) & 1) << 5)); }
__host__ __device__ __forceinline__ void stage_rc(int b, int& R, int& C) { const int st = b / 1024, sb = b % 1024, swz = sb ^ (((sb >> 9) & 1) << 5); R = (st >> 1) * 16 + swz / 64; C = (st & 1) * 32 + (swz % 64) / 2; }
__host__ __device__ __forceinline__ int perm32(int rho) { const int n = rho >> 4, i = rho & 15; return 8 * (i >> 2) + 4 * n + (i & 3); }

struct Unit { int pm, pn; };
struct Gemm { const bf16_t* A; const bf16_t* Bt; int M, N, K; };

struct StaticOrder {
    int nM, nN, nwg, G, c;
    __host__ __device__ void init(int M, int N, int G_, int c_) { nM = M / BM; nN = N / BM; nwg = nM * nN; G = G_; c = c_; }
    __host__ __device__ bool next(int i, Unit& u) const {
        const long L = (long)i * G + c; if (L >= nwg) return false;
        int wgid = (int)L; { const int q = nwg / NXCD, r = nwg % NXCD, xcd = wgid % NXCD, off = wgid / NXCD; wgid = (xcd < r ? xcd * (q + 1) : r * (q + 1) + (xcd - r) * q) + off; }
        const int nig = WGM * nN, gid = wgid / nig, fm = gid * WGM, gsz = (nM - fm) < WGM ? (nM - fm) : WGM;
        u.pm = fm + ((wgid % nig) % gsz); u.pn = (wgid % nig) / gsz; return true;
    }
    __device__ __forceinline__ void a_ready(const Unit&) const {}
    __device__ __forceinline__ void done(const Unit&) const {}
};
__device__ __forceinline__ unsigned cvt_pk_bf16(float lo, float hi) { unsigned r; asm volatile("v_cvt_pk_bf16_f32 %0, %1, %2" : "=v"(r) : "v"(lo), "v"(hi)); return r; }
template <class Epi, class Sched, bool STAMP = false>
__device__ __forceinline__ void gemm_phase(PG8_LAS unsigned char* lds, const Gemm g, const Sched& S, const Epi& E, unsigned long long* stamps) {
    const int tid = threadIdx.x, wid = __builtin_amdgcn_readfirstlane(tid >> 6), lane = tid & 63, wr = wid >> 2, wc = wid & 3, fr = lane & 15, fq = lane >> 4;
    const int K = g.K, nt = K / BK;
    int ts_lo = 0, ts_hi = 0, nts = 0; const unsigned long long rt_entry = STAMP ? (unsigned long long)wall_clock64() : 0ull;
#define PG8_STAMP() do { if (STAMP && wid == 0 && nts < 64) { const unsigned long long _c = (unsigned long long)clock64(); \
        ts_lo = (lane == nts) ? (int)(unsigned)_c : ts_lo; ts_hi = (lane == nts) ? (int)(unsigned)(_c >> 32) : ts_hi; ++nts; } } while (0)
    PG8_STAMP();
    unsigned voffA[2], voffB[2];
#pragma unroll
    for (int i = 0; i < 2; ++i) { int R, C; stage_rc(tid * 16 + i * 8192, R, C); const int Rb = Epi::PERM ? ((R & ~31) + perm32(R & 31)) : R;
        voffA[i] = (unsigned)(R * K + C) * 2u; voffB[i] = (unsigned)(Rb * K + C) * 2u; }
    const size_t kstep = (size_t)(BK * 2);
    const size_t hstep = (size_t)HALF * K * 2;
    const size_t tstep = 2 * hstep;
    const unsigned ldsw = (unsigned)wid * 1024u;
    const int aoff = lds_byte(wr * 64 + fr, fq * 8), boff = lds_byte(wc * 32 + fr, fq * 8);
#define PG8_SA(b, h) (((b) * 2 + (h)) * HTB)
#define PG8_SB(b, h) ((4 + (b) * 2 + (h)) * HTB)
#define PG8_STAGE(bufoff, gbase, voff) do { _Pragma("unroll") for (int _i = 0; _i < 2; ++_i) \
        __builtin_amdgcn_global_load_lds((const unsigned*)((const char*)(gbase) + (voff)[_i]), (PG8_LAS unsigned*)(lds + (bufoff) + ldsw + _i * 8192), 16, 0, 0); } while (0)
#define PG8_LDA(dst, b, h) do { _Pragma("unroll") for (int m = 0; m < 4; ++m) _Pragma("unroll") for (int k = 0; k < 2; ++k) dst[m][k] = *(const PG8_LAS bf16x8*)(lds + PG8_SA(b, h) + aoff + m * 2048 + k * 1024); } while (0)
#define PG8_LDB(dst, b, h) do { _Pragma("unroll") for (int n = 0; n < 2; ++n) _Pragma("unroll") for (int k = 0; k < 2; ++k) dst[n][k] = *(const PG8_LAS bf16x8*)(lds + PG8_SB(b, h) + boff + n * 2048 + k * 1024); } while (0)
#define PG8_MMA(ai, bj, At, Bt) do { __builtin_amdgcn_s_setprio(1); _Pragma("unroll") for (int m = 0; m < 4; ++m) _Pragma("unroll") for (int n = 0; n < 2; ++n) _Pragma("unroll") for (int k = 0; k < 2; ++k) \
        acc[ai][bj][m][n] = __builtin_amdgcn_mfma_f32_16x16x32_bf16(Bt[n][k], At[m][k], acc[ai][bj][m][n], 0, 0, 0); __builtin_amdgcn_s_setprio(0); } while (0)
#define PG8_WAIT_V(n) asm volatile("s_waitcnt vmcnt(" #n ")" ::: "memory")
#define PG8_WAIT_L(n) asm volatile("s_waitcnt lgkmcnt(" #n ")" ::: "memory")
#define PG8_BAR __builtin_amdgcn_s_barrier()
#define PG8_SCHED __builtin_amdgcn_sched_barrier(0)
    Unit cur, nxt; int ui = 0;
    if (!S.next(0, cur)) return;
    f32x4 acc[2][2][4][2];
#pragma unroll
    for (int a = 0; a < 2; ++a)
#pragma unroll
        for (int b = 0; b < 2; ++b)
#pragma unroll
            for (int m = 0; m < 4; ++m)
#pragma unroll
                for (int n = 0; n < 2; ++n) acc[a][b][m][n] = (f32x4){0.f, 0.f, 0.f, 0.f};
    bf16x8 At[4][2], B0[2][2], B1[2][2];
    const char* cA = (const char*)g.A + (size_t)cur.pm * tstep; const char* cB = (const char*)g.Bt + (size_t)cur.pn * tstep;
    S.a_ready(cur);
    PG8_STAGE(PG8_SB(0, 0), cB, voffB); PG8_STAGE(PG8_SA(0, 0), cA, voffA); PG8_STAGE(PG8_SB(0, 1), cB + hstep, voffB); PG8_STAGE(PG8_SA(0, 1), cA + hstep, voffA);
    if (wr == 1) PG8_BAR;
    PG8_WAIT_V(4); PG8_BAR;
    PG8_STAGE(PG8_SB(1, 0), cB + kstep, voffB); PG8_STAGE(PG8_SA(1, 0), cA + kstep, voffA); PG8_STAGE(PG8_SB(1, 1), cB + hstep + kstep, voffB);
    PG8_WAIT_V(6); PG8_BAR;
    PG8_STAMP();
    for (;;) {
        const bool has_next = S.next(ui + 1, nxt);
        const char* nA = has_next ? (const char*)g.A + (size_t)nxt.pm * tstep : cA; const char* nB = has_next ? (const char*)g.Bt + (size_t)nxt.pn * tstep : cB;
        for (int t = 0; t < nt; t += 2) {
            const bool last = (t == nt - 2);
            const char* a1 = cA + (size_t)(t + 1) * kstep;
            const char* a2 = last ? nA : cA + (size_t)(t + 2) * kstep; const char* b2 = last ? nB : cB + (size_t)(t + 2) * kstep;
            const char* a3 = a2 + kstep; const char* b3 = b2 + kstep;
            if (last && has_next) S.a_ready(nxt);
            PG8_LDB(B0, 0, 0); PG8_SCHED; PG8_LDA(At, 0, 0); PG8_STAGE(PG8_SA(1, 1), a1 + hstep, voffA);
            PG8_WAIT_L(8); PG8_BAR; PG8_WAIT_L(0); PG8_MMA(0, 0, At, B0); PG8_BAR; PG8_SCHED;
            PG8_LDB(B1, 0, 1); PG8_STAGE(PG8_SB(0, 0), b2, voffB);
            PG8_BAR; PG8_WAIT_L(0); PG8_MMA(0, 1, At, B1); PG8_BAR;
            PG8_LDA(At, 0, 1); PG8_STAGE(PG8_SA(0, 0), a2, voffA);
            PG8_BAR; PG8_WAIT_L(0); PG8_MMA(1, 0, At, B0); PG8_BAR; PG8_SCHED;
            PG8_STAGE(PG8_SB(0, 1), b2 + hstep, voffB);
            PG8_WAIT_V(6); PG8_BAR; PG8_MMA(1, 1, At, B1); PG8_BAR;
            PG8_LDB(B0, 1, 0); PG8_SCHED; PG8_LDA(At, 1, 0); PG8_STAGE(PG8_SA(0, 1), a2 + hstep, voffA);
            PG8_WAIT_L(8); PG8_BAR; PG8_WAIT_L(0); PG8_MMA(0, 0, At, B0); PG8_BAR; PG8_SCHED;
            PG8_LDB(B1, 1, 1); PG8_STAGE(PG8_SB(1, 0), b3, voffB);
            PG8_BAR; PG8_WAIT_L(0); PG8_MMA(0, 1, At, B1); PG8_BAR;
            PG8_LDA(At, 1, 1); PG8_STAGE(PG8_SA(1, 0), a3, voffA);
            PG8_BAR; PG8_WAIT_L(0); PG8_MMA(1, 0, At, B0); PG8_BAR; PG8_SCHED;
            PG8_STAGE(PG8_SB(1, 1), b3 + hstep, voffB);
            PG8_WAIT_V(6); PG8_BAR; PG8_MMA(1, 1, At, B1); PG8_BAR;
        }
        PG8_STAMP();
        if constexpr (!Epi::AFTER_DRAIN) { E(acc, cur, wr, wc, fr, fq); S.done(cur); }
        PG8_STAMP();
        if (!has_next) break;
#pragma unroll
        for (int a = 0; a < 2; ++a)
#pragma unroll
            for (int b = 0; b < 2; ++b)
#pragma unroll
                for (int m = 0; m < 4; ++m)
#pragma unroll
                    for (int n = 0; n < 2; ++n) acc[a][b][m][n] = (f32x4){0.f, 0.f, 0.f, 0.f};
        cur = nxt; cA = nA; cB = nB; ++ui;
    }
    PG8_WAIT_V(0);
    if (wr == 0) PG8_BAR;
    PG8_BAR;
    if constexpr (Epi::AFTER_DRAIN) { E.fused(acc, cur, wr, wc, fr, fq, lds, wid, lane); S.done(cur); }
    PG8_STAMP();
    if (STAMP && wid == 0) { stamps[lane] = lane < nts ? (((unsigned long long)(unsigned)ts_hi << 32) | (unsigned)ts_lo) : 0ull;
        if (lane == 62) stamps[62] = rt_entry; if (lane == 63) stamps[63] = (unsigned long long)wall_clock64(); }
#undef PG8_STAMP
#undef PG8_SA
#undef PG8_SB
#undef PG8_STAGE
#undef PG8_LDA
#undef PG8_LDB
#undef PG8_MMA
#undef PG8_WAIT_V
#undef PG8_WAIT_L
#undef PG8_BAR
#undef PG8_SCHED
}
}

#define LAS __attribute__((address_space(3)))
using pg8::bf16_t; using pg8::bf16x8; using pg8::f32x4; using pg8::u32x4; using pg8::cvt_pk_bf16;
typedef unsigned u32x2 __attribute__((ext_vector_type(2)));

constexpr int DM = 1024, T_P = 16384, T_S = 256, MT = T_P + T_S, FF = 2816, NH = 24, AW = 1536, MW = 512;
constexpr int SROWS = 2176;
constexpr float RMS_EPS = 1e-6f;
constexpr int NTHREADS = 512, NWAVES = 8;
constexpr int LDS_BYTES = 131072;

constexpr size_t O_YP = 0, O_YS = 16777216, O_SSP = O_YS + 262144, O_CKP = O_SSP + 16384, O_CVP = O_CKP + 6291456,
                 O_SSS = O_CVP + 6291456, O_CKS = O_SSS + 262144, O_CVS = O_CKS + 100663296, O_END = O_CVS + 100663296;

constexpr size_t al256(size_t x) { return (x + 255) & ~(size_t)255; }
constexpr size_t W_IN_B = (size_t)2 * FF * DM * 2, W_OUT_B = (size_t)DM * FF * 2;
constexpr size_t WS_W1IN = 0;
constexpr size_t WS_W2IN = WS_W1IN + 2 * W_IN_B;
constexpr size_t WS_W1OUT = WS_W2IN + 2 * W_IN_B;
constexpr size_t WS_W2OUT = WS_W1OUT + 2 * W_OUT_B;
constexpr size_t WS_WGLU = WS_W2OUT + 2 * W_OUT_B;
constexpr size_t WS_WKV = WS_WGLU + (size_t)2048 * 1024 * 2;
constexpr size_t WS_WQ = WS_WKV + (size_t)3072 * 1024 * 2;
constexpr size_t WS_WO = WS_WQ + (size_t)1536 * 1024 * 2;
constexpr size_t WS_X = WS_WO + (size_t)1024 * 512 * 2;
constexpr size_t WS_XB = WS_X + (size_t)MT * DM * 4;
constexpr size_t WS_H = WS_XB + (size_t)MT * DM * 2;
constexpr size_t WS_Z = WS_H + (size_t)MT * FF * 2;
constexpr size_t WS_SS = WS_Z + (size_t)MT * DM * 2;
constexpr size_t WS_ROPE = al256(WS_SS + (size_t)7 * MT * 4);
constexpr size_t WS_LAM = WS_ROPE + (size_t)MT * 16 * 4;
constexpr size_t WS_LAM64 = WS_LAM + 4096 * 8;
constexpr size_t WS_BRE = WS_LAM64 + 4096 * 8;
constexpr size_t WS_BIM = WS_BRE + 4096 * 64;
constexpr size_t WS_CPK = WS_BIM + 4096 * 64;
constexpr size_t WS_SLOC = WS_CPK + (size_t)64 * 16 * 128 * 2;
constexpr size_t WS_QP = WS_SLOC + (size_t)2 * 128 * 4096 * 8;
constexpr size_t WS_QS = WS_QP + (size_t)2 * 24 * 8192 * 64 * 2;
constexpr size_t WS_KPP = WS_QS + (size_t)32 * 24 * 8 * 64 * 2;
constexpr size_t WS_VTP = WS_KPP + (size_t)2 * 24 * 8192 * 64 * 2;
constexpr size_t WS_KPS = WS_VTP + (size_t)2 * 24 * 8192 * 64 * 2;
constexpr size_t WS_VTS = WS_KPS + (size_t)32 * 24 * SROWS * 64 * 2;
constexpr size_t WS_OBR = WS_VTS + (size_t)32 * 24 * SROWS * 64 * 2;
constexpr size_t WS_LSE = WS_OBR + (size_t)MT * AW * 4;
constexpr size_t WS_OB = al256(WS_LSE + (size_t)MT * 24 * 4);
constexpr size_t WS_BAR = al256(WS_OB + (size_t)MT * MW * 2);
constexpr size_t WS_END = WS_BAR + 256;

struct Params {
    const float *x_prompt, *x_sample, *state_ssm, *cache_k, *cache_v;
    const float *ffn_norm1, *ffn_w1_in, *ffn_w1_out, *ffn_norm2, *ffn_w2_in, *ffn_w2_out, *mix_norm;
    const float *a_re, *a_im, *log_dt, *b_re, *b_im, *c_re, *c_im, *ssm_d, *w_glu;
    const float *kv_norm, *w_kv, *w_q, *w_o, *final_norm;
    float* out;
    unsigned char* ws;
};

__device__ __forceinline__ float wave_sum(float v) {
#pragma unroll
    for (int o = 1; o < 64; o <<= 1) v += __shfl_xor(v, o);
    return v;
}
__device__ __forceinline__ bf16_t f2bf(float f) { return (bf16_t)(cvt_pk_bf16(f, 0.f) & 0xffffu); }
__device__ __forceinline__ float rs_of(float ss) { return rsqrtf(ss * (1.0f / DM) + RMS_EPS); }
#define LDS_FENCE() asm volatile("s_waitcnt lgkmcnt(0)" ::: "memory")

__device__ __forceinline__ void dsincos(double a, double& s, double& c) {
    const double k = rint(a * 0.63661977236758134308);
    double r = fma(-k, 1.5707963267948966, a); r = fma(-k, 6.123233995736766e-17, r);
    const int q = (int)(((long long)k) & 3);
    const double r2 = r * r;
    const double sr = r * (1.0 + r2 * (-1.0 / 6 + r2 * (1.0 / 120 + r2 * (-1.0 / 5040 + r2 * (1.0 / 362880 + r2 * (-1.0 / 39916800 + r2 * (1.0 / 6227020800.0 + r2 * (-1.0 / 1307674368000.0))))))));
    const double cr = 1.0 + r2 * (-0.5 + r2 * (1.0 / 24 + r2 * (-1.0 / 720 + r2 * (1.0 / 40320 + r2 * (-1.0 / 3628800 + r2 * (1.0 / 479001600.0 + r2 * (-1.0 / 87178291200.0 + r2 * (1.0 / 20922789888000.0))))))));
    s = (q == 0) ? sr : (q == 1) ? cr : (q == 2) ? -sr : -cr;
    c = (q == 0) ? cr : (q == 1) ? -sr : (q == 2) ? -cr : sr;
}

__device__ __forceinline__ void tok_info(int row, int& is_s, int& b, int& pos) {
    if (row < T_P) { is_s = 0; b = row >> 13; pos = row & 8191; } else { const int rr = row - T_P; is_s = 1; b = rr >> 3; pos = 2048 + (rr & 7); }
}

__device__ __forceinline__ void wt_item(const float* W, int K, int N, bf16_t* WT, const float* gain, int Nh, LAS float* scr, int item, int lane) {
    const int nblk = N / 32, kb = item / nblk, nb = item % nblk, k0 = 64 * kb, n0 = 32 * nb;
    const int c0 = Nh ? (((n0 >> 7) & 1) * Nh + (n0 >> 8) * 128 + (n0 & 127)) : n0;
    float wv[32];
#pragma unroll
    for (int i = 0; i < 32; ++i) { const int kk = 2 * i + (lane >> 5); wv[i] = W[(size_t)(k0 + kk) * N + c0 + (lane & 31)]; }
#pragma unroll
    for (int i = 0; i < 32; ++i) { const int kk = 2 * i + (lane >> 5); float v = wv[i]; if (gain) v *= gain[k0 + kk]; scr[kk * 33 + (lane & 31)] = v; }
    LDS_FENCE();
    const int c = lane & 7;
#pragma unroll
    for (int j = 0; j < 4; ++j) { const int n = (lane >> 3) + 8 * j; const LAS float* s = scr + (8 * c) * 33 + n;
        u32x4 o; o.x = cvt_pk_bf16(s[0 * 33], s[1 * 33]); o.y = cvt_pk_bf16(s[2 * 33], s[3 * 33]); o.z = cvt_pk_bf16(s[4 * 33], s[5 * 33]); o.w = cvt_pk_bf16(s[6 * 33], s[7 * 33]);
        *(u32x4*)(WT + (size_t)(n0 + n) * K + k0 + 8 * c) = o; }
    LDS_FENCE();
}

__device__ __forceinline__ void phase0(const Params& p, LAS unsigned char* lds) {
    const int tid = threadIdx.x, lane = tid & 63, wave = tid >> 6;
    const int gw = blockIdx.x * NWAVES + wave, NGW = gridDim.x * NWAVES;
    const size_t gt = (size_t)blockIdx.x * NTHREADS + tid, NT = (size_t)gridDim.x * NTHREADS;
    unsigned char* ws = p.ws;
    LAS float* scr = (LAS float*)(lds + wave * 8448);
    constexpr int CPB = (2040 * 1536 / 4) / 512, NCU = 64 * CPB;
    int cu = gw;
#define CP_ISSUE(V, OK, UN) do { OK = (UN) < NCU; if (OK) { const int seg_ = (UN) / CPB, chn_ = (UN) % CPB, kv_ = seg_ >> 5, b_ = seg_ & 31; \
        const f32x4* src_ = (const f32x4*)((kv_ ? p.cache_v : p.cache_k) + (size_t)b_ * (2048 * 1536) + 8 * 1536) + chn_ * 512 + lane; \
        _Pragma("unroll") for (int k_ = 0; k_ < 8; ++k_) V[k_] = __builtin_nontemporal_load(src_ + k_ * 64); } } while (0)
#define CP_STORE(V, OK, UN) do { if (OK) { const int seg_ = (UN) / CPB, chn_ = (UN) % CPB, kv_ = seg_ >> 5, b_ = seg_ & 31; \
        f32x4* dst_ = (f32x4*)(p.out + (kv_ ? O_CVS : O_CKS) + (size_t)b_ * (2048 * 1536)) + chn_ * 512 + lane; \
        _Pragma("unroll") for (int k_ = 0; k_ < 8; ++k_) __builtin_nontemporal_store(V[k_], dst_ + k_ * 64); } } while (0)
    {
        constexpr int I_IN = (DM / 64) * (2 * FF / 32), I_OUT = (FF / 64) * (DM / 32), I_GLU = (DM / 64) * (2048 / 32), I_KV = (DM / 64) * (3072 / 32), I_Q = (DM / 64) * (1536 / 32), I_O = (512 / 64) * (1024 / 32);
        constexpr int NIT = 4 * I_IN + 4 * I_OUT + I_GLU + I_KV + I_Q + I_O;
        for (int it = gw; it < NIT; it += NGW) {
            f32x4 c0[8], c1[8], c2[8]; bool k0, k1, k2; const int u0 = cu, u1 = cu + NGW, u2 = cu + 2 * NGW; cu += 3 * NGW;
            CP_ISSUE(c0, k0, u0); CP_ISSUE(c1, k1, u1); CP_ISSUE(c2, k2, u2);
            do {
            int r = it;
            if (r < 4 * I_IN) { const int w = r / I_IN, l = w & 1, which = w >> 1; r -= w * I_IN;
                const float* W = (which ? p.ffn_w2_in : p.ffn_w1_in) + (size_t)l * DM * 2 * FF; const float* g = (which ? p.ffn_norm2 : p.ffn_norm1) + l * DM;
                bf16_t* WT = (bf16_t*)(ws + (which ? WS_W2IN : WS_W1IN) + l * W_IN_B);
                wt_item(W, DM, 2 * FF, WT, g, FF, scr, r, lane); break; }
            r -= 4 * I_IN;
            if (r < 4 * I_OUT) { const int w = r / I_OUT, l = w & 1, which = w >> 1; r -= w * I_OUT;
                const float* W = (which ? p.ffn_w2_out : p.ffn_w1_out) + (size_t)l * FF * DM;
                bf16_t* WT = (bf16_t*)(ws + (which ? WS_W2OUT : WS_W1OUT) + l * W_OUT_B);
                wt_item(W, FF, DM, WT, nullptr, 0, scr, r, lane); break; }
            r -= 4 * I_OUT;
            if (r < I_GLU) { wt_item(p.w_glu, DM, 2048, (bf16_t*)(ws + WS_WGLU), nullptr, 1024, scr, r, lane); break; }
            r -= I_GLU;
            if (r < I_KV) { wt_item(p.w_kv, DM, 3072, (bf16_t*)(ws + WS_WKV), p.kv_norm, 0, scr, r, lane); break; }
            r -= I_KV;
            if (r < I_Q) { wt_item(p.w_q, DM, 1536, (bf16_t*)(ws + WS_WQ), p.mix_norm + DM, 0, scr, r, lane); break; }
            r -= I_Q;
            wt_item(p.w_o, 512, 1024, (bf16_t*)(ws + WS_WO), nullptr, 0, scr, r, lane);
            } while (0);
            CP_STORE(c0, k0, u0); CP_STORE(c1, k1, u1); CP_STORE(c2, k2, u2);
        }
    }
    {
        float* X = (float*)(ws + WS_X); bf16_t* Xb = (bf16_t*)(ws + WS_XB); float* ss0 = (float*)(ws + WS_SS);
        for (int row = gw; row < MT; row += NGW) {
            f32x4 c0[8]; bool k0; const int u0 = cu; cu += NGW; CP_ISSUE(c0, k0, u0);
            const float* src = row < T_P ? p.x_prompt + (size_t)row * DM : p.x_sample + (size_t)(row - T_P) * DM;
            float s = 0.f;
#pragma unroll
            for (int j = 0; j < 4; ++j) { const f32x4 v = ((const f32x4*)src)[lane + 64 * j]; ((f32x4*)(X + (size_t)row * DM))[lane + 64 * j] = v; s += (v.x * v.x + v.y * v.y) + (v.z * v.z + v.w * v.w);
                u32x2 o; o.x = cvt_pk_bf16(v.x, v.y); o.y = cvt_pk_bf16(v.z, v.w); ((u32x2*)(Xb + (size_t)row * DM))[lane + 64 * j] = o; }
            s = wave_sum(s); if (lane == 0) ss0[row] = s;
            CP_STORE(c0, k0, u0);
        }
    }
    { float* ss = (float*)(ws + WS_SS) + MT; for (size_t i = gt; i < (size_t)6 * MT; i += NT) ss[i] = 0.f; }
    {
        float* rope = (float*)(ws + WS_ROPE);
        for (size_t i = gt; i < (size_t)MT * 8; i += NT) { const int row = (int)(i >> 3), k = (int)(i & 7);
            const int posq = row < T_P ? (row & 8191) : 16384 + ((row - T_P) & 7);
            const double inv = exp(-(double)(2 * k) / 16.0 * 13.122363377404328);
            double s, c; dsincos((double)posq * inv, s, c); rope[i * 2] = (float)c; rope[i * 2 + 1] = (float)s; }
    }
    {
        float* LAM = (float*)(ws + WS_LAM); float* LAM64 = (float*)(ws + WS_LAM64); float* BRE = (float*)(ws + WS_BRE); float* BIM = (float*)(ws + WS_BIM); bf16_t* CPK = (bf16_t*)(ws + WS_CPK);
        for (size_t i = gt; i < 4096; i += NT) { const int g = (int)(i >> 6), pp = (int)(i & 63);
            const double dt = exp((double)p.log_dt[g]), are = p.a_re[i], aim = p.a_im[i];
            double s, c; dsincos(aim * dt, s, c); const double mag = exp(are * dt), lr = mag * c, li = mag * s;
            LAM[2 * i] = (float)lr; LAM[2 * i + 1] = (float)li;
            dsincos(64.0 * aim * dt, s, c); const double m64 = exp(64.0 * are * dt); LAM64[2 * i] = (float)(m64 * c); LAM64[2 * i + 1] = (float)(m64 * s);
            const double den = are * are + aim * aim, nr = lr - 1.0, ni = li;
            const double cr = (nr * are + ni * aim) / den, ci = (ni * are - nr * aim) / den;
#pragma unroll
            for (int h = 0; h < 16; ++h) { const double br = p.b_re[i * 16 + h], bi = p.b_im[i * 16 + h];
                BRE[i * 16 + h] = (float)(cr * br - ci * bi); BIM[i * 16 + h] = (float)(cr * bi + ci * br);
                CPK[((size_t)g * 16 + h) * 128 + pp] = f2bf(p.c_re[((size_t)g * 16 + h) * 64 + pp]); CPK[((size_t)g * 16 + h) * 128 + 64 + pp] = f2bf(-p.c_im[((size_t)g * 16 + h) * 64 + pp]); }
        }
    }
    {
        bf16_t* KPS = (bf16_t*)(ws + WS_KPS);
        const unsigned n = 32u * 2048u * 24u * 8u;
        for (unsigned i = (unsigned)gt; i < n; i += (unsigned)NT) { const int ch = (int)(i & 7); const unsigned hq = i >> 3; const int head = (int)(hq % 24u); const unsigned bp = hq / 24u; const int pos = (int)(bp & 2047), b = (int)(bp >> 11);
            const int br = head >> 3, sh = 2 * br;
            const bool need = br == 0 ? pos >= 1920 : br == 1 ? pos >= 1536 : (pos & 15) < 8;
            if (!need) continue;
            const int r = pos & ((1 << sh) - 1), m = pos >> sh, Lr = (2048 >> sh) + 8;
            const float* src = p.cache_k + (((size_t)b * 2048 + pos) * 24 + head) * 64 + ch * 8;
            const f32x4 a = *(const f32x4*)src, c = *(const f32x4*)(src + 4);
            u32x4 o; o.x = cvt_pk_bf16(a.x, a.y); o.y = cvt_pk_bf16(a.z, a.w); o.z = cvt_pk_bf16(c.x, c.y); o.w = cvt_pk_bf16(c.z, c.w);
            *(u32x4*)(KPS + (((size_t)b * 24 + head) * SROWS + r * Lr + m) * 64 + ch * 8) = o; }
    }
    {
        bf16_t* VTS = (bf16_t*)(ws + WS_VTS);
        LAS bf16_t* T = (LAS bf16_t*)scr;
        for (int it = gw; it < 32 * 208; it += NGW) { const int b = it / 208, rem = it % 208; int head, sub, r, m0;
            if (rem < 16) { head = rem >> 1; sub = rem & 1; r = 0; m0 = 1920 + 64 * sub; }
            else if (rem < 80) { const int x = rem - 16; head = 8 + (x >> 3); sub = x & 7; r = sub >> 1; m0 = 384 + 64 * (sub & 1); }
            else { const int x = rem - 80; head = 16 + (x >> 4); sub = x & 15; r = sub >> 1; m0 = 64 * (sub & 1); }
            const int sh = 2 * (head >> 3), Lr = (2048 >> sh) + 8;
            f32x4 c0[8], c1[8]; bool k0, k1; const int u0 = cu, u1 = cu + NGW; cu += 2 * NGW; CP_ISSUE(c0, k0, u0); CP_ISSUE(c1, k1, u1);
#pragma unroll
            for (int hh = 0; hh < 2; ++hh) { float tv[32];
#pragma unroll
                for (int mm = 0; mm < 32; ++mm) { const int pos = ((m0 + 32 * hh + mm) << sh) + r; tv[mm] = p.cache_v[(((size_t)b * 2048 + pos) * 24 + head) * 64 + lane]; }
#pragma unroll
                for (int mm = 0; mm < 32; ++mm) T[lane * 66 + 32 * hh + mm] = f2bf(tv[mm]); }
            LDS_FENCE();
            bf16_t* dst = VTS + ((size_t)b * 24 + head) * (64 * SROWS) + (size_t)r * 64 * Lr + m0;
#pragma unroll
            for (int j = 0; j < 8; ++j) { const int dd = 8 * j + (lane >> 3), ch = lane & 7; const LAS unsigned* s = (const LAS unsigned*)(T + dd * 66 + 8 * ch);
                u32x4 o; o.x = s[0]; o.y = s[1]; o.z = s[2]; o.w = s[3]; *(u32x4*)(dst + (size_t)dd * Lr + 8 * ch) = o; }
            LDS_FENCE();
            CP_STORE(c0, k0, u0); CP_STORE(c1, k1, u1);
        }
    }
    for (; cu < NCU; cu += NGW) { f32x4 c0[8]; bool k0; CP_ISSUE(c0, k0, cu); CP_STORE(c0, k0, cu); }
#undef CP_ISSUE
#undef CP_STORE
}

struct EpiSwiGLU {
    static constexpr bool PERM = true, AFTER_DRAIN = false;
    bf16_t* H; const float* ss;
    __device__ __forceinline__ void operator()(const f32x4 (&acc)[2][2][4][2], const pg8::Unit& u, int wr, int wc, int fr, int fq) const {
        const int row0 = u.pm * 256 + wr * 64 + fr, col0 = u.pn * 128 + wc * 32 + 8 * fq;
#pragma unroll
        for (int ai = 0; ai < 2; ++ai)
#pragma unroll
            for (int m = 0; m < 4; ++m) { const int row = row0 + ai * 128 + m * 16; const float rs = rs_of(ss[row]);
                float h[8];
#pragma unroll
                for (int n = 0; n < 2; ++n)
#pragma unroll
                    for (int j = 0; j < 4; ++j) { const float g = acc[ai][0][m][n][j] * rs, uu = acc[ai][1][m][n][j] * rs; h[4 * n + j] = g * __builtin_amdgcn_rcpf(1.f + __expf(-g)) * uu; }
                u32x4 w; w.x = cvt_pk_bf16(h[0], h[1]); w.y = cvt_pk_bf16(h[2], h[3]); w.z = cvt_pk_bf16(h[4], h[5]); w.w = cvt_pk_bf16(h[6], h[7]);
                *(u32x4*)(H + (size_t)row * FF + col0) = w; }
    }
};
struct EpiResid {
    static constexpr bool PERM = true, AFTER_DRAIN = false;
    float* X; bf16_t* Xb; float* ss_out; float scale;
    __device__ __forceinline__ void operator()(const f32x4 (&acc)[2][2][4][2], const pg8::Unit& u, int wr, int wc, int fr, int fq) const {
        const int row0 = u.pm * 256 + wr * 64 + fr;
#pragma unroll
        for (int ai = 0; ai < 2; ++ai)
#pragma unroll
            for (int m = 0; m < 4; ++m) { const int row = row0 + ai * 128 + m * 16; float sq = 0.f;
#pragma unroll
                for (int bj = 0; bj < 2; ++bj) { const int col = u.pn * 256 + bj * 128 + wc * 32 + 8 * fq; float* xp = X + (size_t)row * DM + col;
                    f32x4 a = *(const f32x4*)xp, b = *(const f32x4*)(xp + 4); a += acc[ai][bj][m][0] * scale; b += acc[ai][bj][m][1] * scale;
                    *(f32x4*)xp = a; *(f32x4*)(xp + 4) = b; sq += (a.x * a.x + a.y * a.y) + (a.z * a.z + a.w * a.w) + (b.x * b.x + b.y * b.y) + (b.z * b.z + b.w * b.w);
                    u32x4 w; w.x = cvt_pk_bf16(a.x, a.y); w.y = cvt_pk_bf16(a.z, a.w); w.z = cvt_pk_bf16(b.x, b.y); w.w = cvt_pk_bf16(b.z, b.w);
                    *(u32x4*)(Xb + (size_t)row * DM + col) = w; }
                sq += __shfl_xor(sq, 16); sq += __shfl_xor(sq, 32);
                if (fq == 0) unsafeAtomicAdd(ss_out + row, sq); }
    }
};
struct EpiGLU {
    static constexpr bool PERM = true, AFTER_DRAIN = false;
    float* X; bf16_t* Xb; float* ss_out;
    __device__ __forceinline__ void operator()(const f32x4 (&acc)[2][2][4][2], const pg8::Unit& u, int wr, int wc, int fr, int fq) const {
        const int row0 = u.pm * 256 + wr * 64 + fr, col = u.pn * 128 + wc * 32 + 8 * fq;
#pragma unroll
        for (int ai = 0; ai < 2; ++ai)
#pragma unroll
            for (int m = 0; m < 4; ++m) { const int row = row0 + ai * 128 + m * 16; float* xp = X + (size_t)row * DM + col;
                f32x4 a = *(const f32x4*)xp, b = *(const f32x4*)(xp + 4);
#pragma unroll
                for (int j = 0; j < 4; ++j) { a[j] += acc[ai][0][m][0][j] * __builtin_amdgcn_rcpf(1.f + __expf(-acc[ai][1][m][0][j])); b[j] += acc[ai][0][m][1][j] * __builtin_amdgcn_rcpf(1.f + __expf(-acc[ai][1][m][1][j])); }
                *(f32x4*)xp = a; *(f32x4*)(xp + 4) = b;
                float sq = (a.x * a.x + a.y * a.y) + (a.z * a.z + a.w * a.w) + (b.x * b.x + b.y * b.y) + (b.z * b.z + b.w * b.w);
                u32x4 w; w.x = cvt_pk_bf16(a.x, a.y); w.y = cvt_pk_bf16(a.z, a.w); w.z = cvt_pk_bf16(b.x, b.y); w.w = cvt_pk_bf16(b.z, b.w);
                *(u32x4*)(Xb + (size_t)row * DM + col) = w;
                sq += __shfl_xor(sq, 16); sq += __shfl_xor(sq, 32);
                if (fq == 0) unsafeAtomicAdd(ss_out + row, sq); }
    }
};
__device__ __forceinline__ void rope8(f32x4& v0, f32x4& v1, const float* cs, bool rot_wave, int fq) {
    if (rot_wave) {
        const f32x4 c01 = *(const f32x4*)cs, c23 = *(const f32x4*)(cs + 4), c45 = *(const f32x4*)(cs + 8), c67 = *(const f32x4*)(cs + 12);
        const float cc[8] = {c01.x, c01.z, c23.x, c23.z, c45.x, c45.z, c67.x, c67.z}, sn[8] = {c01.y, c01.w, c23.y, c23.w, c45.y, c45.w, c67.y, c67.w};
#pragma unroll
        for (int j = 0; j < 4; ++j) {
            const float p0 = __shfl_xor(v0[j], 16), p1 = __shfl_xor(v1[j], 16);
            const float a0 = fq == 0 ? v0[j] * cc[j] - p0 * sn[j] : v0[j] * cc[j] + p0 * sn[j];
            const float a1 = fq == 0 ? v1[j] * cc[4 + j] - p1 * sn[4 + j] : v1[j] * cc[4 + j] + p1 * sn[4 + j];
            if (fq < 2) { v0[j] = a0; v1[j] = a1; }
        }
    }
}
struct EpiKV {
    static constexpr bool PERM = true, AFTER_DRAIN = false;
    const float* ss; const float* rope; float* out; bf16_t *KPP, *VTP, *KPS, *VTS;
    __device__ __forceinline__ void operator()(const f32x4 (&acc)[2][2][4][2], const pg8::Unit& u, int wr, int wc, int fr, int fq) const {
        const int row0 = u.pm * 256 + wr * 64 + fr; const bool isv = u.pn >= 6; const int pn6 = isv ? u.pn - 6 : u.pn;
        const int dim0 = 32 * (wc & 1) + 8 * fq; const bool rot_wave = !isv && (wc & 1) == 0;
#pragma unroll
        for (int ai = 0; ai < 2; ++ai)
#pragma unroll
            for (int m = 0; m < 4; ++m) { const int row = row0 + ai * 128 + m * 16; const float rs = rs_of(ss[row]);
                int is_s, b, pos; tok_info(row, is_s, b, pos);
#pragma unroll
                for (int bj = 0; bj < 2; ++bj) { const int head = pn6 * 4 + 2 * bj + (wc >> 1), sh = 2 * (head >> 3);
                    f32x4 v0 = acc[ai][bj][m][0] * rs, v1 = acc[ai][bj][m][1] * rs;
                    rope8(v0, v1, rope + (size_t)row * 16, rot_wave, fq);
                    if (is_s) { float* o = out + (isv ? O_CVS : O_CKS) + (((size_t)b * 2048 + (pos - 8)) * 24 + head) * 64 + dim0; *(f32x4*)o = v0; *(f32x4*)(o + 4) = v1; }
                    else if (pos >= 6144) { float* o = out + (isv ? O_CVP : O_CKP) + (((size_t)b * 2048 + (pos - 6144)) * 24 + head) * 64 + dim0; *(f32x4*)o = v0; *(f32x4*)(o + 4) = v1; }
                    const int r = pos & ((1 << sh) - 1), mm = pos >> sh, Lr = is_s ? (2048 >> sh) + 8 : (8192 >> sh);
                    if (!isv) { u32x4 w; w.x = cvt_pk_bf16(v0.x, v0.y); w.y = cvt_pk_bf16(v0.z, v0.w); w.z = cvt_pk_bf16(v1.x, v1.y); w.w = cvt_pk_bf16(v1.z, v1.w);
                        bf16_t* kb = is_s ? KPS + ((size_t)b * 24 + head) * SROWS * 64 : KPP + ((size_t)b * 24 + head) * 8192 * 64;
                        *(u32x4*)(kb + ((size_t)r * Lr + mm) * 64 + dim0) = w; }
                    else { bf16_t* vb = (is_s ? VTS + ((size_t)b * 24 + head) * (64 * SROWS) : VTP + ((size_t)b * 24 + head) * (64 * 8192)) + ((size_t)r * 64 + dim0) * Lr + mm;
#pragma unroll
                        for (int j = 0; j < 4; ++j) { vb[(size_t)j * Lr] = f2bf(v0[j]); vb[(size_t)(4 + j) * Lr] = f2bf(v1[j]); } }
                }
            }
    }
};
struct EpiQ {
    static constexpr bool PERM = true, AFTER_DRAIN = false;
    const float* ss; const float* rope; bf16_t *QP, *QS;
    __device__ __forceinline__ void operator()(const f32x4 (&acc)[2][2][4][2], const pg8::Unit& u, int wr, int wc, int fr, int fq) const {
        const int row0 = u.pm * 256 + wr * 64 + fr; const int dim0 = 32 * (wc & 1) + 8 * fq; const bool rot_wave = (wc & 1) == 0;
#pragma unroll
        for (int ai = 0; ai < 2; ++ai)
#pragma unroll
            for (int m = 0; m < 4; ++m) { const int row = row0 + ai * 128 + m * 16; const float rs = rs_of(ss[row]);
                int is_s, b, pos; tok_info(row, is_s, b, pos);
#pragma unroll
                for (int bj = 0; bj < 2; ++bj) { const int head = u.pn * 4 + 2 * bj + (wc >> 1), sh = 2 * (head >> 3);
                    f32x4 v0 = acc[ai][bj][m][0] * rs, v1 = acc[ai][bj][m][1] * rs;
                    rope8(v0, v1, rope + (size_t)row * 16, rot_wave, fq);
                    v0 *= 0.125f; v1 *= 0.125f;
                    u32x4 w; w.x = cvt_pk_bf16(v0.x, v0.y); w.y = cvt_pk_bf16(v0.z, v0.w); w.z = cvt_pk_bf16(v1.x, v1.y); w.w = cvt_pk_bf16(v1.z, v1.w);
                    const int r = pos & ((1 << sh) - 1), mm = pos >> sh;
                    if (is_s) { const int j = pos - 2048; const int qidx = sh == 0 ? j : sh == 2 ? (j & 3) * 2 + (j >> 2) : j;
                        *(u32x4*)(QS + (((size_t)b * 24 + head) * 8 + qidx) * 64 + dim0) = w; }
                    else *(u32x4*)(QP + (((size_t)b * 24 + head) * 8192 + (size_t)r * (8192 >> sh) + mm) * 64 + dim0) = w;
                }
            }
    }
};

template <class Epi>
__device__ __forceinline__ void run_gemm(LAS unsigned char* lds, const bf16_t* A, const bf16_t* Bt, int N, int K, const Epi& E) {
    pg8::Gemm g; g.A = A; g.Bt = Bt; g.M = MT; g.N = N; g.K = K;
    pg8::StaticOrder S; S.init(MT, N, (int)gridDim.x, (int)blockIdx.x);
    pg8::gemm_phase<Epi, pg8::StaticOrder, false>(lds, g, S, E, nullptr);
}

template <bool FULL>
__device__ __forceinline__ void s5_pass(const Params& p, LAS unsigned char* lds) {
    const int tid = threadIdx.x, lane = tid & 63, wave = tid >> 6, fr = lane & 15, fq = lane >> 4;
    unsigned char* ws = p.ws;
    const float* X = (const float*)(ws + WS_X); const float* ss1 = (const float*)(ws + WS_SS) + MT;
    const float* LAM = (const float*)(ws + WS_LAM); const float* LAM64 = (const float*)(ws + WS_LAM64); const float* BRE = (const float*)(ws + WS_BRE); const float* BIM = (const float*)(ws + WS_BIM);
    const bf16_t* CPK = (const bf16_t*)(ws + WS_CPK); float* SLOC = (float*)(ws + WS_SLOC); bf16_t* Z = (bf16_t*)(ws + WS_Z);
    LAS float* U = (LAS float*)lds;
    LAS bf16_t* Hs = (LAS bf16_t*)(lds + 32768) + wave * (16 * 136);
    const int nitems = FULL ? 2304 : 2048;
    float Bre[16], Bim[16]; float lr = 0.f, li = 0.f, l6r = 0.f, l6i = 0.f, dsk = 0.f; bf16x8 cf[4];
#pragma unroll
    for (int q = 0; q < 16; ++q) { Bre[q] = 0.f; Bim[q] = 0.f; }
#pragma unroll
    for (int kk = 0; kk < 4; ++kk) cf[kk] = (bf16x8){0, 0, 0, 0, 0, 0, 0, 0};
    int go_ld = -1, car_b = -1, car_c = 0; float car_r = 0.f, car_i = 0.f;
    for (int it = blockIdx.x; it < nitems; it += gridDim.x) {
        int is_s, b, c, go, tok0, nt;
        if (it < 2048) { is_s = 0; b = it >> 10; c = (it >> 3) & 127; go = it & 7; tok0 = b * 8192 + c * 64; nt = 64; }
        else { const int x = it - 2048; is_s = 1; b = x >> 3; go = x & 7; c = 0; tok0 = T_P + b * 8; nt = 8; }
        for (int i = tid; i < nt * 32; i += NTHREADS) { const int t = i >> 5, c4 = i & 31, row = tok0 + t; const float rs = rs_of(ss1[row]);
            f32x4 v = *(const f32x4*)(X + (size_t)row * DM + go * 128 + c4 * 4); const f32x4 gg = *(const f32x4*)(p.mix_norm + go * 128 + c4 * 4);
            v = v * rs * gg; *(LAS f32x4*)(U + t * 128 + c4 * 4) = v; }
        __syncthreads();
        const int g = go * 8 + wave, gp = g * 64 + lane;
        if (go != go_ld) {
            go_ld = go; car_b = -1;
#pragma unroll
            for (int q = 0; q < 4; ++q) { const f32x4 a = *(const f32x4*)(BRE + (size_t)gp * 16 + 4 * q), bb = *(const f32x4*)(BIM + (size_t)gp * 16 + 4 * q);
#pragma unroll
                for (int j = 0; j < 4; ++j) { Bre[4 * q + j] = a[j]; Bim[4 * q + j] = bb[j]; } }
            lr = LAM[2 * gp]; li = LAM[2 * gp + 1];
            if (FULL) { l6r = LAM64[2 * gp]; l6i = LAM64[2 * gp + 1];
#pragma unroll
                for (int kk = 0; kk < 4; ++kk) cf[kk] = *(const bf16x8*)(CPK + ((size_t)g * 16 + fr) * 128 + 32 * kk + 8 * fq);
                dsk = p.ssm_d[16 * g + fr]; }
        }
        float hre = 0.f, him = 0.f;
        if (FULL) {
            if (is_s) { const float* s0 = p.state_ssm + ((size_t)b * 4096 + gp) * 2; hre = s0[0]; him = s0[1]; }
            else {
                typedef float f32x2 __attribute__((ext_vector_type(2)));
                if (b != car_b || c < car_c) { car_b = b; car_c = 0; car_r = 0.f; car_i = 0.f; }
                for (int j0 = car_c; j0 < c; j0 += 16) { f32x2 sv[16];
#pragma unroll
                    for (int k = 0; k < 16; ++k) { const int j = (j0 + k < c) ? j0 + k : c - 1; sv[k] = *(const f32x2*)(SLOC + (((size_t)b * 128 + j) * 4096 + gp) * 2); }
#pragma unroll
                    for (int k = 0; k < 16; ++k) if (j0 + k < c) { const float nr = l6r * car_r - l6i * car_i + sv[k].x; car_i = l6r * car_i + l6i * car_r + sv[k].y; car_r = nr; } }
                car_c = c; hre = car_r; him = car_i; }
        }
        for (int t0 = 0; t0 < nt; t0 += 16) {
#pragma unroll 4
            for (int tt = 0; tt < 16; ++tt) {
                if (t0 + tt < nt) {
                    const LAS float* ur = U + (t0 + tt) * 128 + 16 * wave;
                    float bre = 0.f, bim = 0.f;
#pragma unroll
                    for (int q = 0; q < 4; ++q) { const f32x4 uv = *(const LAS f32x4*)(ur + 4 * q);
#pragma unroll
                        for (int j = 0; j < 4; ++j) { bre = fmaf(Bre[4 * q + j], uv[j], bre); bim = fmaf(Bim[4 * q + j], uv[j], bim); } }
                    const float nr = lr * hre - li * him + bre; him = lr * him + li * hre + bim; hre = nr;
                }
                if (FULL) { Hs[tt * 136 + lane] = f2bf(hre); Hs[tt * 136 + 64 + lane] = f2bf(him); }
            }
            if (FULL) {
                LDS_FENCE();
                f32x4 y = {0.f, 0.f, 0.f, 0.f};
#pragma unroll
                for (int kk = 0; kk < 4; ++kk) { const bf16x8 af = *(const LAS bf16x8*)(Hs + fr * 136 + 32 * kk + 8 * fq); y = __builtin_amdgcn_mfma_f32_16x16x32_bf16(af, cf[kk], y, 0, 0, 0); }
#pragma unroll
                for (int e = 0; e < 4; ++e) { const int t = t0 + 4 * fq + e;
                    if (t < nt) { const float yy = y[e] + dsk * U[t * 128 + 16 * wave + fr];
                        const float a = 0.7978845608028654f * (yy + 0.044715f * yy * yy * yy); const float th = 1.f - 2.f * __builtin_amdgcn_rcpf(__expf(2.f * a) + 1.f);
                        Z[(size_t)(tok0 + t) * DM + 16 * g + fr] = f2bf(0.5f * yy * (1.f + th)); } }
                LDS_FENCE();
            }
        }
        if (FULL) {
            if (is_s) { float* o = p.out + O_SSS + ((size_t)b * 4096 + gp) * 2; o[0] = hre; o[1] = him; }
            else if (c == 127) { float* o = p.out + O_SSP + ((size_t)b * 4096 + gp) * 2; o[0] = hre; o[1] = him; }
        } else { float* s = SLOC + (((size_t)b * 128 + c) * 4096 + gp) * 2; s[0] = hre; s[1] = him; }
        __syncthreads();
    }
}

__device__ __forceinline__ void attn_phase(const Params& p) {
    const int tid = threadIdx.x, lane = tid & 63, wave = tid >> 6, fr = lane & 15, fq = lane >> 4;
    const int gw = blockIdx.x * NWAVES + wave, NGW = gridDim.x * NWAVES;
    unsigned char* ws = p.ws;
    const bf16_t *QP = (const bf16_t*)(ws + WS_QP), *QS = (const bf16_t*)(ws + WS_QS), *KPP = (const bf16_t*)(ws + WS_KPP), *VTP = (const bf16_t*)(ws + WS_VTP), *KPS = (const bf16_t*)(ws + WS_KPS), *VTS = (const bf16_t*)(ws + WS_VTS);
    float* OBR = (float*)(ws + WS_OBR); float* LSE = (float*)(ws + WS_LSE);
    constexpr int NP = 2 * 24 * 512, NS = 32 * 104;
    for (int item = gw; item < NP + NS; item += NGW) {
        int is_s, b, head, r, mq0, nqv;
        if (item < NP) { is_s = 0; b = item / 12288; const int rem = item % 12288; head = rem >> 9; const int wt = rem & 511; const int sh = 2 * (head >> 3), per = 512 >> sh; r = wt / per; mq0 = 16 * (wt % per); nqv = 16; }
        else { const int si = item - NP; is_s = 1; b = si / 104; const int rem = si % 104;
            if (rem < 8) { head = rem; r = 0; mq0 = 2048; nqv = 8; }
            else if (rem < 40) { const int x = rem - 8; head = 8 + (x >> 2); r = x & 3; mq0 = 512; nqv = 2; }
            else { const int x = rem - 40; head = 16 + (x >> 3); r = x & 7; mq0 = 128; nqv = 1; } }
        const int sh = 2 * (head >> 3);
        const int Lr = is_s ? (2048 >> sh) + 8 : (8192 >> sh);
        const bf16_t* Kb = (is_s ? KPS + ((size_t)b * 24 + head) * SROWS * 64 : KPP + ((size_t)b * 24 + head) * 8192 * 64) + (size_t)r * Lr * 64;
        const bf16_t* Vb = (is_s ? VTS + ((size_t)b * 24 + head) * (64 * SROWS) : VTP + ((size_t)b * 24 + head) * (64 * 8192)) + (size_t)r * 64 * Lr;
        const int qi = fr < nqv ? fr : nqv - 1;
        const bf16_t* Qrow = is_s ? QS + (((size_t)b * 24 + head) * 8 + r * nqv + qi) * 64 : QP + (((size_t)b * 24 + head) * 8192 + (size_t)r * Lr + mq0 + qi) * 64;
        const bf16x8 q0 = *(const bf16x8*)(Qrow + 8 * fq), q1 = *(const bf16x8*)(Qrow + 32 + 8 * fq);
        const int mk0 = mq0 - 128;
        f32x4 s[9];
#pragma unroll
        for (int blk = 0; blk < 9; ++blk) { int mj = mk0 + 16 * blk + fr; mj = mj < 0 ? 0 : (mj > Lr - 1 ? Lr - 1 : mj);
            const bf16_t* kr = Kb + (size_t)mj * 64 + 8 * fq; const bf16x8 k0 = *(const bf16x8*)kr, k1 = *(const bf16x8*)(kr + 32);
            f32x4 a = {0.f, 0.f, 0.f, 0.f}; a = __builtin_amdgcn_mfma_f32_16x16x32_bf16(k0, q0, a, 0, 0, 0); s[blk] = __builtin_amdgcn_mfma_f32_16x16x32_bf16(k1, q1, a, 0, 0, 0); }
        float mx = -3.0e38f;
#pragma unroll
        for (int blk = 0; blk < 9; ++blk)
#pragma unroll
            for (int e = 0; e < 4; ++e) { const int j = 16 * blk + 4 * fq + e; const bool ok = (j >= fr) && (j <= fr + 128) && (mk0 + j >= 0);
                const float v = ok ? s[blk][e] : -1.0e30f; s[blk][e] = v; mx = fmaxf(mx, v); }
        mx = fmaxf(mx, __shfl_xor(mx, 16)); mx = fmaxf(mx, __shfl_xor(mx, 32));
        float l = 0.f;
#pragma unroll
        for (int blk = 0; blk < 9; ++blk)
#pragma unroll
            for (int e = 0; e < 4; ++e) { const float pe = __expf(s[blk][e] - mx); l += pe; s[blk][e] = pe; }
        l += __shfl_xor(l, 16); l += __shfl_xor(l, 32);
        f32x4 o[4];
#pragma unroll
        for (int db = 0; db < 4; ++db) o[db] = (f32x4){0.f, 0.f, 0.f, 0.f};
#pragma unroll
        for (int pr = 0; pr < 5; ++pr) {
            u32x4 pw; pw.x = cvt_pk_bf16(s[2 * pr][0], s[2 * pr][1]); pw.y = cvt_pk_bf16(s[2 * pr][2], s[2 * pr][3]);
            if (pr < 4) { pw.z = cvt_pk_bf16(s[2 * pr + 1][0], s[2 * pr + 1][1]); pw.w = cvt_pk_bf16(s[2 * pr + 1][2], s[2 * pr + 1][3]); } else { pw.z = 0u; pw.w = 0u; }
            const bf16x8 pf = __builtin_bit_cast(bf16x8, pw);
            int ma = mk0 + 32 * pr + 4 * fq, mb = ma + 16;
            ma = ma < 0 ? 0 : (ma > Lr - 4 ? Lr - 4 : ma); mb = mb < 0 ? 0 : (mb > Lr - 4 ? Lr - 4 : mb);
#pragma unroll
            for (int db = 0; db < 4; ++db) { const bf16_t* vr = Vb + (size_t)(16 * db + fr) * Lr;
                const u32x2 va = *(const u32x2*)(vr + ma), vb = *(const u32x2*)(vr + mb);
                u32x4 vw; vw.x = va.x; vw.y = va.y; vw.z = vb.x; vw.w = vb.y;
                o[db] = __builtin_amdgcn_mfma_f32_16x16x32_bf16(__builtin_bit_cast(bf16x8, vw), pf, o[db], 0, 0, 0); }
        }
        if (fr < nqv) {
            const int pq = ((mq0 + fr) << sh) + r;
            const int token = is_s ? T_P + b * 8 + (pq - 2048) : b * 8192 + pq;
            const float inv = 1.f / l;
#pragma unroll
            for (int db = 0; db < 4; ++db) *(f32x4*)(OBR + (size_t)token * AW + head * 64 + 16 * db + 4 * fq) = o[db] * inv;
            if (fq == 0) LSE[(size_t)token * 24 + head] = mx + logf(l);
        }
    }
}

__device__ __forceinline__ void merge_phase(const Params& p) {
    const size_t gt = (size_t)blockIdx.x * NTHREADS + threadIdx.x, NT = (size_t)gridDim.x * NTHREADS;
    const float* OBR = (const float*)(p.ws + WS_OBR); const float* LSE = (const float*)(p.ws + WS_LSE); bf16_t* OB = (bf16_t*)(p.ws + WS_OB);
    for (size_t i = gt; i < (size_t)MT * 64; i += NT) { const size_t token = i >> 6; const int h = (int)((i >> 3) & 7), ch = (int)(i & 7);
        const float l0 = LSE[token * 24 + h], l1 = LSE[token * 24 + 8 + h], l2 = LSE[token * 24 + 16 + h];
        const float mx = fmaxf(l0, fmaxf(l1, l2)); float w0 = __expf(l0 - mx), w1 = __expf(l1 - mx), w2 = __expf(l2 - mx); const float inv = 1.f / (w0 + w1 + w2); w0 *= inv; w1 *= inv; w2 *= inv;
        const float* o0 = OBR + token * AW + h * 64 + ch * 8;
        const f32x4 a0 = *(const f32x4*)o0, b0 = *(const f32x4*)(o0 + 4), a1 = *(const f32x4*)(o0 + 512), b1 = *(const f32x4*)(o0 + 516), a2 = *(const f32x4*)(o0 + 1024), b2 = *(const f32x4*)(o0 + 1028);
        const f32x4 a = a0 * w0 + a1 * w1 + a2 * w2, bb = b0 * w0 + b1 * w1 + b2 * w2;
        u32x4 w; w.x = cvt_pk_bf16(a.x, a.y); w.y = cvt_pk_bf16(a.z, a.w); w.z = cvt_pk_bf16(bb.x, bb.y); w.w = cvt_pk_bf16(bb.z, bb.w);
        *(u32x4*)(OB + token * MW + h * 64 + ch * 8) = w; }
}

__device__ __forceinline__ void final_phase(const Params& p) {
    const int lane = threadIdx.x & 63, wave = threadIdx.x >> 6;
    const int gw = blockIdx.x * NWAVES + wave, NGW = gridDim.x * NWAVES;
    const float* X = (const float*)(p.ws + WS_X); const float* ss6 = (const float*)(p.ws + WS_SS) + (size_t)6 * MT;
    for (int row = gw; row < MT; row += NGW) { const float rs = rs_of(ss6[row]);
        float* dst = row < T_P ? p.out + O_YP + (size_t)row * DM : p.out + O_YS + (size_t)(row - T_P) * DM;
#pragma unroll
        for (int j = 0; j < 4; ++j) { const f32x4 v = ((const f32x4*)(X + (size_t)row * DM))[lane + 64 * j], g = ((const f32x4*)p.final_norm)[lane + 64 * j]; ((f32x4*)dst)[lane + 64 * j] = v * rs * g; }
    }
}


__device__ __forceinline__ void ctr_barrier(unsigned* cnt, unsigned target) {
    asm volatile("s_waitcnt vmcnt(0)" ::: "memory");
    __syncthreads();
    if (threadIdx.x == 0) {
        __builtin_amdgcn_fence(__ATOMIC_RELEASE, "agent");
        asm volatile("s_waitcnt vmcnt(0)" ::: "memory");
        __hip_atomic_fetch_add(cnt, 1u, __ATOMIC_RELAXED, __HIP_MEMORY_SCOPE_AGENT);
        unsigned sp = 0;
        while (__hip_atomic_load(cnt, __ATOMIC_RELAXED, __HIP_MEMORY_SCOPE_AGENT) < target) { __builtin_amdgcn_s_sleep(1); if (++sp > (1u << 24)) break; }
        __builtin_amdgcn_fence(__ATOMIC_ACQUIRE, "agent");
        asm volatile("s_waitcnt vmcnt(0)" ::: "memory");
    }
    __syncthreads();
}
__global__ void __launch_bounds__(NTHREADS, 2) yoco_fwd(Params p) {
    extern __shared__ __attribute__((aligned(16))) unsigned char shm[];
    LAS unsigned char* lds = (LAS unsigned char*)shm;
    cg::grid_group grid = cg::this_grid();
    unsigned char* ws = p.ws;
    float* X = (float*)(ws + WS_X); bf16_t* Xb = (bf16_t*)(ws + WS_XB); bf16_t* H = (bf16_t*)(ws + WS_H); bf16_t* Z = (bf16_t*)(ws + WS_Z); float* SS = (float*)(ws + WS_SS);
    const float* rope = (const float*)(ws + WS_ROPE);

    phase0(p, lds);
    grid.sync();
    unsigned* gbar = (unsigned*)(ws + WS_BAR);
    { EpiSwiGLU e; e.H = H; e.ss = SS; run_gemm(lds, Xb, (const bf16_t*)(ws + WS_W1IN), 2 * FF, DM, e); }
    ctr_barrier(gbar, 1u * gridDim.x);
    { EpiResid e; e.X = X; e.Xb = Xb; e.ss_out = SS + MT; e.scale = 0.5f; run_gemm(lds, H, (const bf16_t*)(ws + WS_W1OUT), DM, FF, e); }
    ctr_barrier(gbar, 2u * gridDim.x);
    s5_pass<false>(p, lds);
    ctr_barrier(gbar, 3u * gridDim.x);
    s5_pass<true>(p, lds);
    ctr_barrier(gbar, 4u * gridDim.x);
    { EpiGLU e; e.X = X; e.Xb = Xb; e.ss_out = SS + 2 * MT; run_gemm(lds, Z, (const bf16_t*)(ws + WS_WGLU), 2048, DM, e); }
    ctr_barrier(gbar, 5u * gridDim.x);
    { EpiSwiGLU e; e.H = H; e.ss = SS + 2 * MT; run_gemm(lds, Xb, (const bf16_t*)(ws + WS_W2IN), 2 * FF, DM, e); }
    ctr_barrier(gbar, 6u * gridDim.x);
    { EpiResid e; e.X = X; e.Xb = Xb; e.ss_out = SS + 3 * MT; e.scale = 0.5f; run_gemm(lds, H, (const bf16_t*)(ws + WS_W2OUT), DM, FF, e); }
    ctr_barrier(gbar, 7u * gridDim.x);
    { EpiKV e; e.ss = SS + 3 * MT; e.rope = rope; e.out = p.out; e.KPP = (bf16_t*)(ws + WS_KPP); e.VTP = (bf16_t*)(ws + WS_VTP); e.KPS = (bf16_t*)(ws + WS_KPS); e.VTS = (bf16_t*)(ws + WS_VTS);
      run_gemm(lds, Xb, (const bf16_t*)(ws + WS_WKV), 3072, DM, e); }
    { EpiSwiGLU e; e.H = H; e.ss = SS + 3 * MT; run_gemm(lds, Xb, (const bf16_t*)(ws + WS_W1IN + W_IN_B), 2 * FF, DM, e); }
    ctr_barrier(gbar, 8u * gridDim.x);
    { EpiResid e; e.X = X; e.Xb = Xb; e.ss_out = SS + 4 * MT; e.scale = 0.5f; run_gemm(lds, H, (const bf16_t*)(ws + WS_W1OUT + W_OUT_B), DM, FF, e); }
    ctr_barrier(gbar, 9u * gridDim.x);
    { EpiQ e; e.ss = SS + 4 * MT; e.rope = rope; e.QP = (bf16_t*)(ws + WS_QP); e.QS = (bf16_t*)(ws + WS_QS); run_gemm(lds, Xb, (const bf16_t*)(ws + WS_WQ), 1536, DM, e); }
    ctr_barrier(gbar, 10u * gridDim.x);
    attn_phase(p);
    ctr_barrier(gbar, 11u * gridDim.x);
    merge_phase(p);
    ctr_barrier(gbar, 12u * gridDim.x);
    { EpiResid e; e.X = X; e.Xb = Xb; e.ss_out = SS + 5 * MT; e.scale = 1.0f; run_gemm(lds, (const bf16_t*)(ws + WS_OB), (const bf16_t*)(ws + WS_WO), DM, MW, e); }
    ctr_barrier(gbar, 13u * gridDim.x);
    { EpiSwiGLU e; e.H = H; e.ss = SS + 5 * MT; run_gemm(lds, Xb, (const bf16_t*)(ws + WS_W2IN + W_IN_B), 2 * FF, DM, e); }
    ctr_barrier(gbar, 14u * gridDim.x);
    { EpiResid e; e.X = X; e.Xb = Xb; e.ss_out = SS + 6 * MT; e.scale = 0.5f; run_gemm(lds, H, (const bf16_t*)(ws + WS_W2OUT + W_OUT_B), DM, FF, e); }
    ctr_barrier(gbar, 15u * gridDim.x);
    final_phase(p);
}

extern "C" void kernel_launch(void* const* d_in, const int* in_sizes, int n_in, void* d_out, int out_size, void* d_ws, size_t ws_size, hipStream_t stream) {
    static int grid_blocks = 0;
    if (grid_blocks == 0) {
        if (n_in != 26 || (size_t)out_size != O_END || ws_size < WS_END) { fprintf(stderr, "kernel_launch: unexpected shapes (n_in %d, out %d, ws %zu; need ws >= %zu)\n", n_in, out_size, ws_size, (size_t)WS_END); grid_blocks = -1; return; }
        int dev = 0, cus = 0, per_cu = 0;
        hipGetDevice(&dev);
        hipDeviceGetAttribute(&cus, hipDeviceAttributeMultiprocessorCount, dev);
        if (hipFuncSetAttribute((const void*)yoco_fwd, hipFuncAttributeMaxDynamicSharedMemorySize, LDS_BYTES) != hipSuccess) { fprintf(stderr, "kernel_launch: hipFuncSetAttribute failed\n"); grid_blocks = -1; return; }
        if (hipOccupancyMaxActiveBlocksPerMultiprocessor(&per_cu, (const void*)yoco_fwd, NTHREADS, LDS_BYTES) != hipSuccess || per_cu < 1) { fprintf(stderr, "kernel_launch: occupancy query failed (%d)\n", per_cu); per_cu = 1; (void)hipGetLastError(); }
        if (per_cu > 1) per_cu = 1;
        grid_blocks = cus * per_cu;
    }
    if (grid_blocks < 0) return;
    Params p{};
    const float** f = (const float**)&p;
    for (int i = 0; i < 26; ++i) f[i] = (const float*)d_in[i];
    p.out = (float*)d_out; p.ws = (unsigned char*)d_ws;
    void* args[] = {&p};
    (void)hipMemsetAsync((unsigned char*)d_ws + WS_BAR, 0, 256, stream);
    hipError_t e = hipLaunchCooperativeKernel((const void*)yoco_fwd, dim3(grid_blocks), dim3(NTHREADS), args, LDS_BYTES, stream);
    if (e != hipSuccess) fprintf(stderr, "cooperative launch failed: %s (grid %d)\n", hipGetErrorString(e), grid_blocks);
}
```

```cpp
#include <hip/hip_runtime.h>
#include <hip/hip_cooperative_groups.h>
#include <cstdio>
#include <cstdint>
namespace cg = cooperative_groups;
namespace pg8 {
#define PG8_LAS __attribute__((address_space(3)))
typedef unsigned short bf16_t;
typedef short bf16x8 __attribute__((ext_vector_type(8)));
typedef float f32x4 __attribute__((ext_vector_type(4)));
typedef unsigned u32x4 __attribute__((ext_vector_type(4)));
constexpr int BM = 256, BK = 64, HALF = 128, HTB = HALF * BK * 2  , STAGE_BYTES = 8 * HTB, NXCD = 8, WGM = 8;

__host__ __device__ __forceinline__ int lds_byte(int r, int c) { const int st = (r >> 4) * 2 + (c >> 5), rr = r & 15, cc = c & 31, ob = rr * 64 + cc * 2; return st * 1024 + (ob ^ (((ob >> 9) & 1) << 5)); }
__host__ __device__ __forceinline__ void stage_rc(int b, int& R, int& C) { const int st = b / 1024, sb = b % 1024, swz = sb ^ (((sb >> 9) & 1) << 5); R = (st >> 1) * 16 + swz / 64; C = (st & 1) * 32 + (swz % 64) / 2; }
__host__ __device__ __forceinline__ int perm32(int rho) { const int n = rho >> 4, i = rho & 15; return 8 * (i >> 2) + 4 * n + (i & 3); }

struct Unit { int pm, pn; };
struct Gemm { const bf16_t* A; const bf16_t* Bt; int M, N, K; };

struct StaticOrder {
    int nM, nN, nwg, G, c;
    __host__ __device__ void init(int M, int N, int G_, int c_) { nM = M / BM; nN = N / BM; nwg = nM * nN; G = G_; c = c_; }
    __host__ __device__ bool next(int i, Unit& u) const {
        const long L = (long)i * G + c; if (L >= nwg) return false;
        int wgid = (int)L; { const int q = nwg / NXCD, r = nwg % NXCD, xcd = wgid % NXCD, off = wgid / NXCD; wgid = (xcd < r ? xcd * (q + 1) : r * (q + 1) + (xcd - r) * q) + off; }
        const int nig = WGM * nN, gid = wgid / nig, fm = gid * WGM, gsz = (nM - fm) < WGM ? (nM - fm) : WGM;
        u.pm = fm + ((wgid % nig) % gsz); u.pn = (wgid % nig) / gsz; return true;
    }
    __device__ __forceinline__ void a_ready(const Unit&) const {}
    __device__ __forceinline__ void done(const Unit&) const {}
};
__device__ __forceinline__ unsigned cvt_pk_bf16(float lo, float hi) { unsigned r; asm volatile("v_cvt_pk_bf16_f32 %0, %1, %2" : "=v"(r) : "v"(lo), "v"(hi)); return r; }
template <class Epi, class Sched, bool STAMP = false>
__device__ __forceinline__ void gemm_phase(PG8_LAS unsigned char* lds, const Gemm g, const Sched& S, const Epi& E, unsigned long long* stamps) {
    int tid_ = threadIdx.x; asm volatile("" : "+v"(tid_));
    const int tid = tid_, wid = __builtin_amdgcn_readfirstlane(tid >> 6), lane = tid & 63, wr = wid >> 2, wc = wid & 3, fr = lane & 15, fq = lane >> 4;
    const int K = g.K, nt = K / BK;
    int ts_lo = 0, ts_hi = 0, nts = 0; const unsigned long long rt_entry = STAMP ? (unsigned long long)wall_clock64() : 0ull;
#define PG8_STAMP() do { if (STAMP && wid == 0 && nts < 64) { const unsigned long long _c = (unsigned long long)clock64(); \
        ts_lo = (lane == nts) ? (int)(unsigned)_c : ts_lo; ts_hi = (lane == nts) ? (int)(unsigned)(_c >> 32) : ts_hi; ++nts; } } while (0)
    PG8_STAMP();
    unsigned voffA[2], voffB[2];
#pragma unroll
    for (int i = 0; i < 2; ++i) { int R, C; stage_rc(tid * 16 + i * 8192, R, C); const int Rb = Epi::PERM ? ((R & ~31) + perm32(R & 31)) : R;
        voffA[i] = (unsigned)(R * K + C) * 2u; voffB[i] = (unsigned)(Rb * K + C) * 2u; }
    const size_t kstep = (size_t)(BK * 2);
    const size_t hstep = (size_t)HALF * K * 2;
    const size_t tstep = 2 * hstep;
    const unsigned ldsw = (unsigned)wid * 1024u;
    const int aoff = lds_byte(wr * 64 + fr, fq * 8), boff = lds_byte(wc * 32 + fr, fq * 8);
#define PG8_SA(b, h) (((b) * 2 + (h)) * HTB)
#define PG8_SB(b, h) ((4 + (b) * 2 + (h)) * HTB)
#define PG8_STAGE(bufoff, gbase, voff) do { _Pragma("unroll") for (int _i = 0; _i < 2; ++_i) \
        __builtin_amdgcn_global_load_lds((const unsigned*)((const char*)(gbase) + (voff)[_i]), (PG8_LAS unsigned*)(lds + (bufoff) + ldsw + _i * 8192), 16, 0, 0); } while (0)
#define PG8_LDA(dst, b, h) do { _Pragma("unroll") for (int m = 0; m < 4; ++m) _Pragma("unroll") for (int k = 0; k < 2; ++k) dst[m][k] = *(const PG8_LAS bf16x8*)(lds + PG8_SA(b, h) + aoff + m * 2048 + k * 1024); } while (0)
#define PG8_LDB(dst, b, h) do { _Pragma("unroll") for (int n = 0; n < 2; ++n) _Pragma("unroll") for (int k = 0; k < 2; ++k) dst[n][k] = *(const PG8_LAS bf16x8*)(lds + PG8_SB(b, h) + boff + n * 2048 + k * 1024); } while (0)
#define PG8_MMA(ai, bj, At, Bt) do { __builtin_amdgcn_s_setprio(1); _Pragma("unroll") for (int m = 0; m < 4; ++m) _Pragma("unroll") for (int n = 0; n < 2; ++n) _Pragma("unroll") for (int k = 0; k < 2; ++k) \
        acc[ai][bj][m][n] = __builtin_amdgcn_mfma_f32_16x16x32_bf16(Bt[n][k], At[m][k], acc[ai][bj][m][n], 0, 0, 0); __builtin_amdgcn_s_setprio(0); } while (0)
#define PG8_WAIT_V(n) asm volatile("s_waitcnt vmcnt(" #n ")" ::: "memory")
#define PG8_WAIT_L(n) asm volatile("s_waitcnt lgkmcnt(" #n ")" ::: "memory")
#define PG8_BAR __builtin_amdgcn_s_barrier()
#define PG8_SCHED __builtin_amdgcn_sched_barrier(0)
    Unit cur, nxt; int ui = 0;
    if (!S.next(0, cur)) return;
    f32x4 acc[2][2][4][2];
#pragma unroll
    for (int a = 0; a < 2; ++a)
#pragma unroll
        for (int b = 0; b < 2; ++b)
#pragma unroll
            for (int m = 0; m < 4; ++m)
#pragma unroll
                for (int n = 0; n < 2; ++n) acc[a][b][m][n] = (f32x4){0.f, 0.f, 0.f, 0.f};
    bf16x8 At[4][2], B0[2][2], B1[2][2];
    const char* cA = (const char*)g.A + (size_t)cur.pm * tstep; const char* cB = (const char*)g.Bt + (size_t)cur.pn * tstep;
    S.a_ready(cur);
    PG8_STAGE(PG8_SB(0, 0), cB, voffB); PG8_STAGE(PG8_SA(0, 0), cA, voffA); PG8_STAGE(PG8_SB(0, 1), cB + hstep, voffB); PG8_STAGE(PG8_SA(0, 1), cA + hstep, voffA);
    if (wr == 1) PG8_BAR;
    PG8_WAIT_V(4); PG8_BAR;
    PG8_STAGE(PG8_SB(1, 0), cB + kstep, voffB); PG8_STAGE(PG8_SA(1, 0), cA + kstep, voffA); PG8_STAGE(PG8_SB(1, 1), cB + hstep + kstep, voffB);
    PG8_WAIT_V(6); PG8_BAR;
    PG8_STAMP();
    for (;;) {
        const bool has_next = S.next(ui + 1, nxt);
        const char* nA = has_next ? (const char*)g.A + (size_t)nxt.pm * tstep : cA; const char* nB = has_next ? (const char*)g.Bt + (size_t)nxt.pn * tstep : cB;
        for (int t = 0; t < nt; t += 2) {
            const bool last = (t == nt - 2);
            const char* a1 = cA + (size_t)(t + 1) * kstep;
            const char* a2 = last ? nA : cA + (size_t)(t + 2) * kstep; const char* b2 = last ? nB : cB + (size_t)(t + 2) * kstep;
            const char* a3 = a2 + kstep; const char* b3 = b2 + kstep;
            if (last && has_next) S.a_ready(nxt);
            PG8_LDB(B0, 0, 0); PG8_SCHED; PG8_LDA(At, 0, 0); PG8_STAGE(PG8_SA(1, 1), a1 + hstep, voffA);
            PG8_WAIT_L(8); PG8_BAR; PG8_WAIT_L(0); PG8_MMA(0, 0, At, B0); PG8_BAR; PG8_SCHED;
            PG8_LDB(B1, 0, 1); PG8_STAGE(PG8_SB(0, 0), b2, voffB);
            PG8_BAR; PG8_WAIT_L(0); PG8_MMA(0, 1, At, B1); PG8_BAR;
            PG8_LDA(At, 0, 1); PG8_STAGE(PG8_SA(0, 0), a2, voffA);
            PG8_BAR; PG8_WAIT_L(0); PG8_MMA(1, 0, At, B0); PG8_BAR; PG8_SCHED;
            PG8_STAGE(PG8_SB(0, 1), b2 + hstep, voffB);
            PG8_WAIT_V(6); PG8_BAR; PG8_MMA(1, 1, At, B1); PG8_BAR;
            PG8_LDB(B0, 1, 0); PG8_SCHED; PG8_LDA(At, 1, 0); PG8_STAGE(PG8_SA(0, 1), a2 + hstep, voffA);
            PG8_WAIT_L(8); PG8_BAR; PG8_WAIT_L(0); PG8_MMA(0, 0, At, B0); PG8_BAR; PG8_SCHED;
            PG8_LDB(B1, 1, 1); PG8_STAGE(PG8_SB(1, 0), b3, voffB);
            PG8_BAR; PG8_WAIT_L(0); PG8_MMA(0, 1, At, B1); PG8_BAR;
            PG8_LDA(At, 1, 1); PG8_STAGE(PG8_SA(1, 0), a3, voffA);
            PG8_BAR; PG8_WAIT_L(0); PG8_MMA(1, 0, At, B0); PG8_BAR; PG8_SCHED;
            PG8_STAGE(PG8_SB(1, 1), b3 + hstep, voffB);
            PG8_WAIT_V(6); PG8_BAR; PG8_MMA(1, 1, At, B1); PG8_BAR;
        }
        PG8_STAMP();
        if constexpr (!Epi::AFTER_DRAIN) { E(acc, cur, wr, wc, fr, fq); S.done(cur); }
        PG8_STAMP();
        if (!has_next) break;
#pragma unroll
        for (int a = 0; a < 2; ++a)
#pragma unroll
            for (int b = 0; b < 2; ++b)
#pragma unroll
                for (int m = 0; m < 4; ++m)
#pragma unroll
                    for (int n = 0; n < 2; ++n) acc[a][b][m][n] = (f32x4){0.f, 0.f, 0.f, 0.f};
        cur = nxt; cA = nA; cB = nB; ++ui;
    }
    PG8_WAIT_V(0);
    if (wr == 0) PG8_BAR;
    PG8_BAR;
    if constexpr (Epi::AFTER_DRAIN) { E.fused(acc, cur, wr, wc, fr, fq, lds, wid, lane); S.done(cur); }
    PG8_STAMP();
    if (STAMP && wid == 0) { stamps[lane] = lane < nts ? (((unsigned long long)(unsigned)ts_hi << 32) | (unsigned)ts_lo) : 0ull;
        if (lane == 62) stamps[62] = rt_entry; if (lane == 63) stamps[63] = (unsigned long long)wall_clock64(); }
#undef PG8_STAMP
#undef PG8_SA
#undef PG8_SB
#undef PG8_STAGE
#undef PG8_LDA
#undef PG8_LDB
#undef PG8_MMA
#undef PG8_WAIT_V
#undef PG8_WAIT_L
#undef PG8_BAR
#undef PG8_SCHED
}
}

#define LAS __attribute__((address_space(3)))
using pg8::bf16_t; using pg8::bf16x8; using pg8::f32x4; using pg8::u32x4; using pg8::cvt_pk_bf16;
typedef unsigned u32x2 __attribute__((ext_vector_type(2)));

constexpr int DM = 1024, T_P = 16384, T_S = 256, MT = T_P + T_S, FF = 2816, NH = 24, AW = 1536, MW = 512;
constexpr int SROWS = 2176;
constexpr float RMS_EPS = 1e-6f;
constexpr int NTHREADS = 512, NWAVES = 8;
constexpr int LDS_BYTES = 131072;

constexpr size_t O_YP = 0, O_YS = 16777216, O_SSP = O_YS + 262144, O_CKP = O_SSP + 16384, O_CVP = O_CKP + 6291456,
                 O_SSS = O_CVP + 6291456, O_CKS = O_SSS + 262144, O_CVS = O_CKS + 100663296, O_END = O_CVS + 100663296;

constexpr size_t al256(size_t x) { return (x + 255) & ~(size_t)255; }
constexpr size_t W_IN_B = (size_t)2 * FF * DM * 2, W_OUT_B = (size_t)DM * FF * 2;
constexpr size_t WS_W1IN = 0;
constexpr size_t WS_W2IN = WS_W1IN + 2 * W_IN_B;
constexpr size_t WS_W1OUT = WS_W2IN + 2 * W_IN_B;
constexpr size_t WS_W2OUT = WS_W1OUT + 2 * W_OUT_B;
constexpr size_t WS_WGLU = WS_W2OUT + 2 * W_OUT_B;
constexpr size_t WS_WKV = WS_WGLU + (size_t)2048 * 1024 * 2;
constexpr size_t WS_WQ = WS_WKV + (size_t)3072 * 1024 * 2;
constexpr size_t WS_WO = WS_WQ + (size_t)1536 * 1024 * 2;
constexpr size_t WS_X = WS_WO + (size_t)1024 * 512 * 2;
constexpr size_t WS_XB = WS_X + (size_t)MT * DM * 4;
constexpr size_t WS_H = WS_XB + (size_t)MT * DM * 2;
constexpr size_t WS_Z = WS_H + (size_t)MT * FF * 2;
constexpr size_t WS_SS = WS_Z + (size_t)MT * DM * 2;
constexpr size_t WS_ROPE = al256(WS_SS + (size_t)7 * MT * 4);
constexpr size_t WS_LAM = WS_ROPE + (size_t)MT * 16 * 4;
constexpr size_t WS_LAM64 = WS_LAM + 4096 * 8;
constexpr size_t WS_BRE = WS_LAM64 + 4096 * 8;
constexpr size_t WS_BIM = WS_BRE + 4096 * 64;
constexpr size_t WS_CPK = WS_BIM + 4096 * 64;
constexpr size_t WS_SLOC = WS_CPK + (size_t)64 * 16 * 128 * 2;
constexpr size_t WS_QP = WS_SLOC + (size_t)2 * 128 * 4096 * 8;
constexpr size_t WS_QS = WS_QP + (size_t)2 * 24 * 8192 * 64 * 2;
constexpr size_t WS_KPP = WS_QS + (size_t)32 * 24 * 8 * 64 * 2;
constexpr size_t WS_VTP = WS_KPP + (size_t)2 * 24 * 8192 * 64 * 2;
constexpr size_t WS_KPS = WS_VTP + (size_t)2 * 24 * 8192 * 64 * 2;
constexpr size_t WS_VTS = WS_KPS + (size_t)32 * 24 * SROWS * 64 * 2;
constexpr size_t WS_OBR = WS_VTS + (size_t)32 * 24 * SROWS * 64 * 2;
constexpr size_t WS_LSE = WS_OBR + (size_t)MT * AW * 4;
constexpr size_t WS_OB = al256(WS_LSE + (size_t)MT * 24 * 4);
constexpr size_t WS_BAR = al256(WS_OB + (size_t)MT * MW * 2);
constexpr size_t WS_END = WS_BAR + 256;

struct Params {
    const float *x_prompt, *x_sample, *state_ssm, *cache_k, *cache_v;
    const float *ffn_norm1, *ffn_w1_in, *ffn_w1_out, *ffn_norm2, *ffn_w2_in, *ffn_w2_out, *mix_norm;
    const float *a_re, *a_im, *log_dt, *b_re, *b_im, *c_re, *c_im, *ssm_d, *w_glu;
    const float *kv_norm, *w_kv, *w_q, *w_o, *final_norm;
    float* out;
    unsigned char* ws;
};

__device__ __forceinline__ int tid_opaque() { int t = threadIdx.x; asm volatile("" : "+v"(t)); return t; }
constexpr int CPB = (2040 * 1536 / 4) / 512, NCU_ALL = 64 * CPB;
constexpr int NCU_S5A = 2048 * 8, NCU_S5B = 2304 * 8, NCU0 = NCU_ALL - NCU_S5A - NCU_S5B;
__device__ __forceinline__ float wave_sum(float v) {
#pragma unroll
    for (int o = 1; o < 64; o <<= 1) v += __shfl_xor(v, o);
    return v;
}
__device__ __forceinline__ bf16_t f2bf(float f) { return (bf16_t)(cvt_pk_bf16(f, 0.f) & 0xffffu); }
__device__ __forceinline__ float rs_of(float ss) { return rsqrtf(ss * (1.0f / DM) + RMS_EPS); }
#define LDS_FENCE() asm volatile("s_waitcnt lgkmcnt(0)" ::: "memory")

__device__ __forceinline__ void dsincos(double a, double& s, double& c) {
    const double k = rint(a * 0.63661977236758134308);
    double r = fma(-k, 1.5707963267948966, a); r = fma(-k, 6.123233995736766e-17, r);
    const int q = (int)(((long long)k) & 3);
    const double r2 = r * r;
    const double sr = r * (1.0 + r2 * (-1.0 / 6 + r2 * (1.0 / 120 + r2 * (-1.0 / 5040 + r2 * (1.0 / 362880 + r2 * (-1.0 / 39916800 + r2 * (1.0 / 6227020800.0 + r2 * (-1.0 / 1307674368000.0))))))));
    const double cr = 1.0 + r2 * (-0.5 + r2 * (1.0 / 24 + r2 * (-1.0 / 720 + r2 * (1.0 / 40320 + r2 * (-1.0 / 3628800 + r2 * (1.0 / 479001600.0 + r2 * (-1.0 / 87178291200.0 + r2 * (1.0 / 20922789888000.0))))))));
    s = (q == 0) ? sr : (q == 1) ? cr : (q == 2) ? -sr : -cr;
    c = (q == 0) ? cr : (q == 1) ? -sr : (q == 2) ? -cr : sr;
}

__device__ __forceinline__ void tok_info(int row, int& is_s, int& b, int& pos) {
    if (row < T_P) { is_s = 0; b = row >> 13; pos = row & 8191; } else { const int rr = row - T_P; is_s = 1; b = rr >> 3; pos = 2048 + (rr & 7); }
}

__device__ __forceinline__ void wt_item(const float* W, int K, int N, bf16_t* WT, const float* gain, int Nh, LAS float* scr, int item, int lane) {
    const int nblk = N / 32, kb = item / nblk, nb = item % nblk, k0 = 64 * kb, n0 = 32 * nb;
    const int c0 = Nh ? (((n0 >> 7) & 1) * Nh + (n0 >> 8) * 128 + (n0 & 127)) : n0;
    float wv[32];
#pragma unroll
    for (int i = 0; i < 32; ++i) { const int kk = 2 * i + (lane >> 5); wv[i] = W[(size_t)(k0 + kk) * N + c0 + (lane & 31)]; }
#pragma unroll
    for (int i = 0; i < 32; ++i) { const int kk = 2 * i + (lane >> 5); float v = wv[i]; if (gain) v *= gain[k0 + kk]; scr[kk * 33 + (lane & 31)] = v; }
    LDS_FENCE();
    const int c = lane & 7;
#pragma unroll
    for (int j = 0; j < 4; ++j) { const int n = (lane >> 3) + 8 * j; const LAS float* s = scr + (8 * c) * 33 + n;
        u32x4 o; o.x = cvt_pk_bf16(s[0 * 33], s[1 * 33]); o.y = cvt_pk_bf16(s[2 * 33], s[3 * 33]); o.z = cvt_pk_bf16(s[4 * 33], s[5 * 33]); o.w = cvt_pk_bf16(s[6 * 33], s[7 * 33]);
        *(u32x4*)(WT + (size_t)(n0 + n) * K + k0 + 8 * c) = o; }
    LDS_FENCE();
}

__device__ __forceinline__ void phase0(const Params& p, LAS unsigned char* lds) {
    const int tid = tid_opaque(), lane = tid & 63, wave = tid >> 6;
    const int gw = blockIdx.x * NWAVES + wave, NGW = gridDim.x * NWAVES;
    const size_t gt = (size_t)blockIdx.x * NTHREADS + tid, NT = (size_t)gridDim.x * NTHREADS;
    unsigned char* ws = p.ws;
    LAS float* scr = (LAS float*)(lds + wave * 8448);
    constexpr int NCU = NCU0;
    int cu = gw;
#define CP_ISSUE(V, OK, UN) do { OK = (UN) < NCU; if (OK) { const int seg_ = (UN) / CPB, chn_ = (UN) % CPB, kv_ = seg_ >> 5, b_ = seg_ & 31; \
        const f32x4* src_ = (const f32x4*)((kv_ ? p.cache_v : p.cache_k) + (size_t)b_ * (2048 * 1536) + 8 * 1536) + chn_ * 512 + lane; \
        _Pragma("unroll") for (int k_ = 0; k_ < 8; ++k_) V[k_] = __builtin_nontemporal_load(src_ + k_ * 64); } } while (0)
#define CP_STORE(V, OK, UN) do { if (OK) { const int seg_ = (UN) / CPB, chn_ = (UN) % CPB, kv_ = seg_ >> 5, b_ = seg_ & 31; \
        f32x4* dst_ = (f32x4*)(p.out + (kv_ ? O_CVS : O_CKS) + (size_t)b_ * (2048 * 1536)) + chn_ * 512 + lane; \
        _Pragma("unroll") for (int k_ = 0; k_ < 8; ++k_) __builtin_nontemporal_store(V[k_], dst_ + k_ * 64); } } while (0)
    {
        constexpr int I_IN = (DM / 64) * (2 * FF / 32), I_OUT = (FF / 64) * (DM / 32), I_GLU = (DM / 64) * (2048 / 32), I_KV = (DM / 64) * (3072 / 32), I_Q = (DM / 64) * (1536 / 32), I_O = (512 / 64) * (1024 / 32);
        constexpr int NIT = 4 * I_IN + 4 * I_OUT + I_GLU + I_KV + I_Q + I_O;
        for (int it = gw; it < NIT; it += NGW) {
            f32x4 c0[8], c1[8]; bool k0, k1; const int u0 = cu, u1 = cu + NGW; cu += 2 * NGW;
            CP_ISSUE(c0, k0, u0); CP_ISSUE(c1, k1, u1);
            do {
            int r = it;
            if (r < 4 * I_IN) { const int w = r / I_IN, l = w & 1, which = w >> 1; r -= w * I_IN;
                const float* W = (which ? p.ffn_w2_in : p.ffn_w1_in) + (size_t)l * DM * 2 * FF; const float* g = (which ? p.ffn_norm2 : p.ffn_norm1) + l * DM;
                bf16_t* WT = (bf16_t*)(ws + (which ? WS_W2IN : WS_W1IN) + l * W_IN_B);
                wt_item(W, DM, 2 * FF, WT, g, FF, scr, r, lane); break; }
            r -= 4 * I_IN;
            if (r < 4 * I_OUT) { const int w = r / I_OUT, l = w & 1, which = w >> 1; r -= w * I_OUT;
                const float* W = (which ? p.ffn_w2_out : p.ffn_w1_out) + (size_t)l * FF * DM;
                bf16_t* WT = (bf16_t*)(ws + (which ? WS_W2OUT : WS_W1OUT) + l * W_OUT_B);
                wt_item(W, FF, DM, WT, nullptr, 0, scr, r, lane); break; }
            r -= 4 * I_OUT;
            if (r < I_GLU) { wt_item(p.w_glu, DM, 2048, (bf16_t*)(ws + WS_WGLU), nullptr, 1024, scr, r, lane); break; }
            r -= I_GLU;
            if (r < I_KV) { wt_item(p.w_kv, DM, 3072, (bf16_t*)(ws + WS_WKV), p.kv_norm, 0, scr, r, lane); break; }
            r -= I_KV;
            if (r < I_Q) { wt_item(p.w_q, DM, 1536, (bf16_t*)(ws + WS_WQ), p.mix_norm + DM, 0, scr, r, lane); break; }
            r -= I_Q;
            wt_item(p.w_o, 512, 1024, (bf16_t*)(ws + WS_WO), nullptr, 0, scr, r, lane);
            } while (0);
            CP_STORE(c0, k0, u0); CP_STORE(c1, k1, u1);
        }
    }
    {
        float* X = (float*)(ws + WS_X); bf16_t* Xb = (bf16_t*)(ws + WS_XB); float* ss0 = (float*)(ws + WS_SS);
        for (int row = gw; row < MT; row += NGW) {
            f32x4 c0[8]; bool k0; const int u0 = cu; cu += NGW; CP_ISSUE(c0, k0, u0);
            const float* src = row < T_P ? p.x_prompt + (size_t)row * DM : p.x_sample + (size_t)(row - T_P) * DM;
            float s = 0.f;
#pragma unroll
            for (int j = 0; j < 4; ++j) { const f32x4 v = ((const f32x4*)src)[lane + 64 * j]; ((f32x4*)(X + (size_t)row * DM))[lane + 64 * j] = v; s += (v.x * v.x + v.y * v.y) + (v.z * v.z + v.w * v.w);
                u32x2 o; o.x = cvt_pk_bf16(v.x, v.y); o.y = cvt_pk_bf16(v.z, v.w); ((u32x2*)(Xb + (size_t)row * DM))[lane + 64 * j] = o; }
            s = wave_sum(s); if (lane == 0) ss0[row] = s;
            CP_STORE(c0, k0, u0);
        }
    }
    { float* ss = (float*)(ws + WS_SS) + MT; for (size_t i = gt; i < (size_t)6 * MT; i += NT) ss[i] = 0.f; }
    {
        float* rope = (float*)(ws + WS_ROPE);
        for (size_t i = gt; i < (size_t)MT * 8; i += NT) { const int row = (int)(i >> 3), k = (int)(i & 7);
            const int posq = row < T_P ? (row & 8191) : 16384 + ((row - T_P) & 7);
            const double inv = exp(-(double)(2 * k) / 16.0 * 13.122363377404328);
            double s, c; dsincos((double)posq * inv, s, c); rope[i * 2] = (float)c; rope[i * 2 + 1] = (float)s; }
    }
    {
        float* LAM = (float*)(ws + WS_LAM); float* LAM64 = (float*)(ws + WS_LAM64); float* BRE = (float*)(ws + WS_BRE); float* BIM = (float*)(ws + WS_BIM); bf16_t* CPK = (bf16_t*)(ws + WS_CPK);
        for (size_t i = gt; i < 4096; i += NT) { const int g = (int)(i >> 6), pp = (int)(i & 63);
            const double dt = exp((double)p.log_dt[g]), are = p.a_re[i], aim = p.a_im[i];
            double s, c; dsincos(aim * dt, s, c); const double mag = exp(are * dt), lr = mag * c, li = mag * s;
            LAM[2 * i] = (float)lr; LAM[2 * i + 1] = (float)li;
            dsincos(64.0 * aim * dt, s, c); const double m64 = exp(64.0 * are * dt); LAM64[2 * i] = (float)(m64 * c); LAM64[2 * i + 1] = (float)(m64 * s);
            const double den = are * are + aim * aim, nr = lr - 1.0, ni = li;
            const double cr = (nr * are + ni * aim) / den, ci = (ni * are - nr * aim) / den;
#pragma unroll
            for (int h = 0; h < 16; ++h) { const double br = p.b_re[i * 16 + h], bi = p.b_im[i * 16 + h];
                BRE[i * 16 + h] = (float)(cr * br - ci * bi); BIM[i * 16 + h] = (float)(cr * bi + ci * br);
                CPK[((size_t)g * 16 + h) * 128 + pp] = f2bf(p.c_re[((size_t)g * 16 + h) * 64 + pp]); CPK[((size_t)g * 16 + h) * 128 + 64 + pp] = f2bf(-p.c_im[((size_t)g * 16 + h) * 64 + pp]); }
        }
    }
    {
        bf16_t* KPS = (bf16_t*)(ws + WS_KPS);
        const unsigned n = 32u * 2048u * 24u * 8u;
        for (unsigned i = (unsigned)gt; i < n; i += (unsigned)NT) { const int ch = (int)(i & 7); const unsigned hq = i >> 3; const int head = (int)(hq % 24u); const unsigned bp = hq / 24u; const int pos = (int)(bp & 2047), b = (int)(bp >> 11);
            const int br = head >> 3, sh = 2 * br;
            const bool need = br == 0 ? pos >= 1920 : br == 1 ? pos >= 1536 : (pos & 15) < 8;
            if (!need) continue;
            const int r = pos & ((1 << sh) - 1), m = pos >> sh, Lr = (2048 >> sh) + 8;
            const float* src = p.cache_k + (((size_t)b * 2048 + pos) * 24 + head) * 64 + ch * 8;
            const f32x4 a = *(const f32x4*)src, c = *(const f32x4*)(src + 4);
            u32x4 o; o.x = cvt_pk_bf16(a.x, a.y); o.y = cvt_pk_bf16(a.z, a.w); o.z = cvt_pk_bf16(c.x, c.y); o.w = cvt_pk_bf16(c.z, c.w);
            *(u32x4*)(KPS + (((size_t)b * 24 + head) * SROWS + r * Lr + m) * 64 + ch * 8) = o; }
    }
    {
        bf16_t* VTS = (bf16_t*)(ws + WS_VTS);
        LAS bf16_t* T = (LAS bf16_t*)scr;
        for (int it = gw; it < 32 * 208; it += NGW) { const int b = it / 208, rem = it % 208; int head, sub, r, m0;
            if (rem < 16) { head = rem >> 1; sub = rem & 1; r = 0; m0 = 1920 + 64 * sub; }
            else if (rem < 80) { const int x = rem - 16; head = 8 + (x >> 3); sub = x & 7; r = sub >> 1; m0 = 384 + 64 * (sub & 1); }
            else { const int x = rem - 80; head = 16 + (x >> 4); sub = x & 15; r = sub >> 1; m0 = 64 * (sub & 1); }
            const int sh = 2 * (head >> 3), Lr = (2048 >> sh) + 8;
            f32x4 c0[8], c1[8]; bool k0, k1; const int u0 = cu, u1 = cu + NGW; cu += 2 * NGW; CP_ISSUE(c0, k0, u0); CP_ISSUE(c1, k1, u1);
#pragma unroll
            for (int hh = 0; hh < 2; ++hh) { float tv[32];
#pragma unroll
                for (int mm = 0; mm < 32; ++mm) { const int pos = ((m0 + 32 * hh + mm) << sh) + r; tv[mm] = p.cache_v[(((size_t)b * 2048 + pos) * 24 + head) * 64 + lane]; }
#pragma unroll
                for (int mm = 0; mm < 32; ++mm) T[lane * 66 + 32 * hh + mm] = f2bf(tv[mm]); }
            LDS_FENCE();
            bf16_t* dst = VTS + ((size_t)b * 24 + head) * (64 * SROWS) + (size_t)r * 64 * Lr + m0;
#pragma unroll
            for (int j = 0; j < 8; ++j) { const int dd = 8 * j + (lane >> 3), ch = lane & 7; const LAS unsigned* s = (const LAS unsigned*)(T + dd * 66 + 8 * ch);
                u32x4 o; o.x = s[0]; o.y = s[1]; o.z = s[2]; o.w = s[3]; *(u32x4*)(dst + (size_t)dd * Lr + 8 * ch) = o; }
            LDS_FENCE();
            CP_STORE(c0, k0, u0); CP_STORE(c1, k1, u1);
        }
    }
    for (; cu < NCU; cu += NGW) { f32x4 c0[8]; bool k0; CP_ISSUE(c0, k0, cu); CP_STORE(c0, k0, cu); }
#undef CP_ISSUE
#undef CP_STORE
#undef NCU_LIM
}

struct EpiSwiGLU {
    static constexpr bool PERM = true, AFTER_DRAIN = false;
    bf16_t* H; const float* ss;
    __device__ __forceinline__ void operator()(const f32x4 (&acc)[2][2][4][2], const pg8::Unit& u, int wr, int wc, int fr, int fq) const {
        const int row0 = u.pm * 256 + wr * 64 + fr, col0 = u.pn * 128 + wc * 32 + 8 * fq;
#pragma unroll
        for (int ai = 0; ai < 2; ++ai)
#pragma unroll
            for (int m = 0; m < 4; ++m) { const int row = row0 + ai * 128 + m * 16; const float rs = rs_of(ss[row]);
                float h[8];
#pragma unroll
                for (int n = 0; n < 2; ++n)
#pragma unroll
                    for (int j = 0; j < 4; ++j) { const float g = acc[ai][0][m][n][j] * rs, uu = acc[ai][1][m][n][j] * rs; h[4 * n + j] = g * __builtin_amdgcn_rcpf(1.f + __expf(-g)) * uu; }
                u32x4 w; w.x = cvt_pk_bf16(h[0], h[1]); w.y = cvt_pk_bf16(h[2], h[3]); w.z = cvt_pk_bf16(h[4], h[5]); w.w = cvt_pk_bf16(h[6], h[7]);
                *(u32x4*)(H + (size_t)row * FF + col0) = w; }
    }
};
struct EpiResid {
    static constexpr bool PERM = true, AFTER_DRAIN = false;
    float* X; bf16_t* Xb; float* ss_out; float scale;
    __device__ __forceinline__ void operator()(const f32x4 (&acc)[2][2][4][2], const pg8::Unit& u, int wr, int wc, int fr, int fq) const {
        const int row0 = u.pm * 256 + wr * 64 + fr;
#pragma unroll
        for (int ai = 0; ai < 2; ++ai)
#pragma unroll
            for (int m = 0; m < 4; ++m) { const int row = row0 + ai * 128 + m * 16; float sq = 0.f;
#pragma unroll
                for (int bj = 0; bj < 2; ++bj) { const int col = u.pn * 256 + bj * 128 + wc * 32 + 8 * fq; float* xp = X + (size_t)row * DM + col;
                    f32x4 a = *(const f32x4*)xp, b = *(const f32x4*)(xp + 4); a += acc[ai][bj][m][0] * scale; b += acc[ai][bj][m][1] * scale;
                    *(f32x4*)xp = a; *(f32x4*)(xp + 4) = b; sq += (a.x * a.x + a.y * a.y) + (a.z * a.z + a.w * a.w) + (b.x * b.x + b.y * b.y) + (b.z * b.z + b.w * b.w);
                    u32x4 w; w.x = cvt_pk_bf16(a.x, a.y); w.y = cvt_pk_bf16(a.z, a.w); w.z = cvt_pk_bf16(b.x, b.y); w.w = cvt_pk_bf16(b.z, b.w);
                    *(u32x4*)(Xb + (size_t)row * DM + col) = w; }
                sq += __shfl_xor(sq, 16); sq += __shfl_xor(sq, 32);
                if (fq == 0) unsafeAtomicAdd(ss_out + row, sq); }
    }
};
struct EpiGLU {
    static constexpr bool PERM = true, AFTER_DRAIN = false;
    float* X; bf16_t* Xb; float* ss_out;
    __device__ __forceinline__ void operator()(const f32x4 (&acc)[2][2][4][2], const pg8::Unit& u, int wr, int wc, int fr, int fq) const {
        const int row0 = u.pm * 256 + wr * 64 + fr, col = u.pn * 128 + wc * 32 + 8 * fq;
#pragma unroll
        for (int ai = 0; ai < 2; ++ai)
#pragma unroll
            for (int m = 0; m < 4; ++m) { const int row = row0 + ai * 128 + m * 16; float* xp = X + (size_t)row * DM + col;
                f32x4 a = *(const f32x4*)xp, b = *(const f32x4*)(xp + 4);
#pragma unroll
                for (int j = 0; j < 4; ++j) { a[j] += acc[ai][0][m][0][j] * __builtin_amdgcn_rcpf(1.f + __expf(-acc[ai][1][m][0][j])); b[j] += acc[ai][0][m][1][j] * __builtin_amdgcn_rcpf(1.f + __expf(-acc[ai][1][m][1][j])); }
                *(f32x4*)xp = a; *(f32x4*)(xp + 4) = b;
                float sq = (a.x * a.x + a.y * a.y) + (a.z * a.z + a.w * a.w) + (b.x * b.x + b.y * b.y) + (b.z * b.z + b.w * b.w);
                u32x4 w; w.x = cvt_pk_bf16(a.x, a.y); w.y = cvt_pk_bf16(a.z, a.w); w.z = cvt_pk_bf16(b.x, b.y); w.w = cvt_pk_bf16(b.z, b.w);
                *(u32x4*)(Xb + (size_t)row * DM + col) = w;
                sq += __shfl_xor(sq, 16); sq += __shfl_xor(sq, 32);
                if (fq == 0) unsafeAtomicAdd(ss_out + row, sq); }
    }
};
__device__ __forceinline__ void rope8(f32x4& v0, f32x4& v1, const float* cs, bool rot_wave, int fq) {
    if (rot_wave) {
        const f32x4 c01 = *(const f32x4*)cs, c23 = *(const f32x4*)(cs + 4), c45 = *(const f32x4*)(cs + 8), c67 = *(const f32x4*)(cs + 12);
        const float cc[8] = {c01.x, c01.z, c23.x, c23.z, c45.x, c45.z, c67.x, c67.z}, sn[8] = {c01.y, c01.w, c23.y, c23.w, c45.y, c45.w, c67.y, c67.w};
#pragma unroll
        for (int j = 0; j < 4; ++j) {
            const float p0 = __shfl_xor(v0[j], 16), p1 = __shfl_xor(v1[j], 16);
            const float a0 = fq == 0 ? v0[j] * cc[j] - p0 * sn[j] : v0[j] * cc[j] + p0 * sn[j];
            const float a1 = fq == 0 ? v1[j] * cc[4 + j] - p1 * sn[4 + j] : v1[j] * cc[4 + j] + p1 * sn[4 + j];
            if (fq < 2) { v0[j] = a0; v1[j] = a1; }
        }
    }
}
struct EpiKV {
    static constexpr bool PERM = true, AFTER_DRAIN = false;
    const float* ss; const float* rope; float* out; bf16_t *KPP, *VTP, *KPS, *VTS;
    __device__ __forceinline__ void operator()(const f32x4 (&acc)[2][2][4][2], const pg8::Unit& u, int wr, int wc, int fr, int fq) const {
        const int row0 = u.pm * 256 + wr * 64 + fr; const bool isv = u.pn >= 6; const int pn6 = isv ? u.pn - 6 : u.pn;
        const int dim0 = 32 * (wc & 1) + 8 * fq; const bool rot_wave = !isv && (wc & 1) == 0;
#pragma unroll
        for (int ai = 0; ai < 2; ++ai)
#pragma unroll
            for (int m = 0; m < 4; ++m) { const int row = row0 + ai * 128 + m * 16; const float rs = rs_of(ss[row]);
                int is_s, b, pos; tok_info(row, is_s, b, pos);
#pragma unroll
                for (int bj = 0; bj < 2; ++bj) { const int head = pn6 * 4 + 2 * bj + (wc >> 1), sh = 2 * (head >> 3);
                    f32x4 v0 = acc[ai][bj][m][0] * rs, v1 = acc[ai][bj][m][1] * rs;
                    rope8(v0, v1, rope + (size_t)row * 16, rot_wave, fq);
                    if (is_s) { float* o = out + (isv ? O_CVS : O_CKS) + (((size_t)b * 2048 + (pos - 8)) * 24 + head) * 64 + dim0; *(f32x4*)o = v0; *(f32x4*)(o + 4) = v1; }
                    else if (pos >= 6144) { float* o = out + (isv ? O_CVP : O_CKP) + (((size_t)b * 2048 + (pos - 6144)) * 24 + head) * 64 + dim0; *(f32x4*)o = v0; *(f32x4*)(o + 4) = v1; }
                    const int r = pos & ((1 << sh) - 1), mm = pos >> sh, Lr = is_s ? (2048 >> sh) + 8 : (8192 >> sh);
                    if (!isv) { u32x4 w; w.x = cvt_pk_bf16(v0.x, v0.y); w.y = cvt_pk_bf16(v0.z, v0.w); w.z = cvt_pk_bf16(v1.x, v1.y); w.w = cvt_pk_bf16(v1.z, v1.w);
                        bf16_t* kb = is_s ? KPS + ((size_t)b * 24 + head) * SROWS * 64 : KPP + ((size_t)b * 24 + head) * 8192 * 64;
                        *(u32x4*)(kb + ((size_t)r * Lr + mm) * 64 + dim0) = w; }
                    else { bf16_t* vb = (is_s ? VTS + ((size_t)b * 24 + head) * (64 * SROWS) : VTP + ((size_t)b * 24 + head) * (64 * 8192)) + ((size_t)r * 64 + dim0) * Lr + mm;
#pragma unroll
                        for (int j = 0; j < 4; ++j) { vb[(size_t)j * Lr] = f2bf(v0[j]); vb[(size_t)(4 + j) * Lr] = f2bf(v1[j]); } }
                }
            }
    }
};
struct EpiQ {
    static constexpr bool PERM = true, AFTER_DRAIN = false;
    const float* ss; const float* rope; bf16_t *QP, *QS;
    __device__ __forceinline__ void operator()(const f32x4 (&acc)[2][2][4][2], const pg8::Unit& u, int wr, int wc, int fr, int fq) const {
        const int row0 = u.pm * 256 + wr * 64 + fr; const int dim0 = 32 * (wc & 1) + 8 * fq; const bool rot_wave = (wc & 1) == 0;
#pragma unroll
        for (int ai = 0; ai < 2; ++ai)
#pragma unroll
            for (int m = 0; m < 4; ++m) { const int row = row0 + ai * 128 + m * 16; const float rs = rs_of(ss[row]);
                int is_s, b, pos; tok_info(row, is_s, b, pos);
#pragma unroll
                for (int bj = 0; bj < 2; ++bj) { const int head = u.pn * 4 + 2 * bj + (wc >> 1), sh = 2 * (head >> 3);
                    f32x4 v0 = acc[ai][bj][m][0] * rs, v1 = acc[ai][bj][m][1] * rs;
                    rope8(v0, v1, rope + (size_t)row * 16, rot_wave, fq);
                    v0 *= 0.125f; v1 *= 0.125f;
                    u32x4 w; w.x = cvt_pk_bf16(v0.x, v0.y); w.y = cvt_pk_bf16(v0.z, v0.w); w.z = cvt_pk_bf16(v1.x, v1.y); w.w = cvt_pk_bf16(v1.z, v1.w);
                    const int r = pos & ((1 << sh) - 1), mm = pos >> sh;
                    if (is_s) { const int j = pos - 2048; const int qidx = sh == 0 ? j : sh == 2 ? (j & 3) * 2 + (j >> 2) : j;
                        *(u32x4*)(QS + (((size_t)b * 24 + head) * 8 + qidx) * 64 + dim0) = w; }
                    else *(u32x4*)(QP + (((size_t)b * 24 + head) * 8192 + (size_t)r * (8192 >> sh) + mm) * 64 + dim0) = w;
                }
            }
    }
};

template <class Epi>
__device__ __forceinline__ void run_gemm(LAS unsigned char* lds, const bf16_t* A, const bf16_t* Bt, int N, int K, const Epi& E) {
    pg8::Gemm g; g.A = A; g.Bt = Bt; g.M = MT; g.N = N; g.K = K;
    pg8::StaticOrder S; S.init(MT, N, (int)gridDim.x, (int)blockIdx.x);
    pg8::gemm_phase<Epi, pg8::StaticOrder, false>(lds, g, S, E, nullptr);
}

template <bool FULL>
__device__ __forceinline__ void s5_pass(const Params& p, LAS unsigned char* lds) {
    const int tid = tid_opaque(), lane = tid & 63, wave = tid >> 6, fr = lane & 15, fq = lane >> 4;
    unsigned char* ws = p.ws;
    const float* X = (const float*)(ws + WS_X); const float* ss1 = (const float*)(ws + WS_SS) + MT;
    const float* LAM = (const float*)(ws + WS_LAM); const float* LAM64 = (const float*)(ws + WS_LAM64); const float* BRE = (const float*)(ws + WS_BRE); const float* BIM = (const float*)(ws + WS_BIM);
    const bf16_t* CPK = (const bf16_t*)(ws + WS_CPK); float* SLOC = (float*)(ws + WS_SLOC); bf16_t* Z = (bf16_t*)(ws + WS_Z);
    LAS float* U = (LAS float*)lds;
    LAS bf16_t* Hs = (LAS bf16_t*)(lds + 32768) + wave * (16 * 136);
    const int nitems = FULL ? 2304 : 2048;
    float Bre[16], Bim[16]; float lr = 0.f, li = 0.f, l6r = 0.f, l6i = 0.f, dsk = 0.f; bf16x8 cf[4];
#pragma unroll
    for (int q = 0; q < 16; ++q) { Bre[q] = 0.f; Bim[q] = 0.f; }
#pragma unroll
    for (int kk = 0; kk < 4; ++kk) cf[kk] = (bf16x8){0, 0, 0, 0, 0, 0, 0, 0};
    int go_ld = -1, car_b = -1, car_c = 0; float car_r = 0.f, car_i = 0.f;
    for (int it = blockIdx.x; it < nitems; it += gridDim.x) {
        f32x4 cpv[8]; const int cun = NCU0 + (FULL ? NCU_S5A : 0) + it * 8 + wave;
        { const int seg_ = cun / CPB, chn_ = cun % CPB, kv_ = seg_ >> 5, b_ = seg_ & 31;
          const f32x4* src_ = (const f32x4*)((kv_ ? p.cache_v : p.cache_k) + (size_t)b_ * (2048 * 1536) + 8 * 1536) + chn_ * 512 + lane;
#pragma unroll
          for (int k_ = 0; k_ < 8; ++k_) cpv[k_] = __builtin_nontemporal_load(src_ + k_ * 64); }
        int is_s, b, c, go, tok0, nt;
        if (it < 2048) { is_s = 0; b = it >> 10; c = (it >> 3) & 127; go = it & 7; tok0 = b * 8192 + c * 64; nt = 64; }
        else { const int x = it - 2048; is_s = 1; b = x >> 3; go = x & 7; c = 0; tok0 = T_P + b * 8; nt = 8; }
        for (int i = tid; i < nt * 32; i += NTHREADS) { const int t = i >> 5, c4 = i & 31, row = tok0 + t; const float rs = rs_of(ss1[row]);
            f32x4 v = *(const f32x4*)(X + (size_t)row * DM + go * 128 + c4 * 4); const f32x4 gg = *(const f32x4*)(p.mix_norm + go * 128 + c4 * 4);
            v = v * rs * gg; *(LAS f32x4*)(U + t * 128 + c4 * 4) = v; }
        __syncthreads();
        const int g = go * 8 + wave, gp = g * 64 + lane;
        if (go != go_ld) {
            go_ld = go; car_b = -1;
#pragma unroll
            for (int q = 0; q < 4; ++q) { const f32x4 a = *(const f32x4*)(BRE + (size_t)gp * 16 + 4 * q), bb = *(const f32x4*)(BIM + (size_t)gp * 16 + 4 * q);
#pragma unroll
                for (int j = 0; j < 4; ++j) { Bre[4 * q + j] = a[j]; Bim[4 * q + j] = bb[j]; } }
            lr = LAM[2 * gp]; li = LAM[2 * gp + 1];
            if (FULL) { l6r = LAM64[2 * gp]; l6i = LAM64[2 * gp + 1];
#pragma unroll
                for (int kk = 0; kk < 4; ++kk) cf[kk] = *(const bf16x8*)(CPK + ((size_t)g * 16 + fr) * 128 + 32 * kk + 8 * fq);
                dsk = p.ssm_d[16 * g + fr]; }
        }
        float hre = 0.f, him = 0.f;
        if (FULL) {
            if (is_s) { const float* s0 = p.state_ssm + ((size_t)b * 4096 + gp) * 2; hre = s0[0]; him = s0[1]; }
            else {
                typedef float f32x2 __attribute__((ext_vector_type(2)));
                if (b != car_b || c < car_c) { car_b = b; car_c = 0; car_r = 0.f; car_i = 0.f; }
                for (int j0 = car_c; j0 < c; j0 += 16) { f32x2 sv[16];
#pragma unroll
                    for (int k = 0; k < 16; ++k) { const int j = (j0 + k < c) ? j0 + k : c - 1; sv[k] = *(const f32x2*)(SLOC + (((size_t)b * 128 + j) * 4096 + gp) * 2); }
#pragma unroll
                    for (int k = 0; k < 16; ++k) if (j0 + k < c) { const float nr = l6r * car_r - l6i * car_i + sv[k].x; car_i = l6r * car_i + l6i * car_r + sv[k].y; car_r = nr; } }
                car_c = c; hre = car_r; him = car_i; }
        }
        for (int t0 = 0; t0 < nt; t0 += 16) {
#pragma unroll 4
            for (int tt = 0; tt < 16; ++tt) {
                if (t0 + tt < nt) {
                    const LAS float* ur = U + (t0 + tt) * 128 + 16 * wave;
                    float bre = 0.f, bim = 0.f;
#pragma unroll
                    for (int q = 0; q < 4; ++q) { const f32x4 uv = *(const LAS f32x4*)(ur + 4 * q);
#pragma unroll
                        for (int j = 0; j < 4; ++j) { bre = fmaf(Bre[4 * q + j], uv[j], bre); bim = fmaf(Bim[4 * q + j], uv[j], bim); } }
                    const float nr = lr * hre - li * him + bre; him = lr * him + li * hre + bim; hre = nr;
                }
                if (FULL) { Hs[tt * 136 + lane] = f2bf(hre); Hs[tt * 136 + 64 + lane] = f2bf(him); }
            }
            if (FULL) {
                LDS_FENCE();
                f32x4 y = {0.f, 0.f, 0.f, 0.f};
#pragma unroll
                for (int kk = 0; kk < 4; ++kk) { const bf16x8 af = *(const LAS bf16x8*)(Hs + fr * 136 + 32 * kk + 8 * fq); y = __builtin_amdgcn_mfma_f32_16x16x32_bf16(af, cf[kk], y, 0, 0, 0); }
#pragma unroll
                for (int e = 0; e < 4; ++e) { const int t = t0 + 4 * fq + e;
                    if (t < nt) { const float yy = y[e] + dsk * U[t * 128 + 16 * wave + fr];
                        const float a = 0.7978845608028654f * (yy + 0.044715f * yy * yy * yy); const float th = 1.f - 2.f * __builtin_amdgcn_rcpf(__expf(2.f * a) + 1.f);
                        Z[(size_t)(tok0 + t) * DM + 16 * g + fr] = f2bf(0.5f * yy * (1.f + th)); } }
                LDS_FENCE();
            }
        }
        if (FULL) {
            if (is_s) { float* o = p.out + O_SSS + ((size_t)b * 4096 + gp) * 2; o[0] = hre; o[1] = him; }
            else if (c == 127) { float* o = p.out + O_SSP + ((size_t)b * 4096 + gp) * 2; o[0] = hre; o[1] = him; }
        } else { float* s = SLOC + (((size_t)b * 128 + c) * 4096 + gp) * 2; s[0] = hre; s[1] = him; }
        { const int seg_ = cun / CPB, chn_ = cun % CPB, kv_ = seg_ >> 5, b_ = seg_ & 31;
          f32x4* dst_ = (f32x4*)(p.out + (kv_ ? O_CVS : O_CKS) + (size_t)b_ * (2048 * 1536)) + chn_ * 512 + lane;
#pragma unroll
          for (int k_ = 0; k_ < 8; ++k_) __builtin_nontemporal_store(cpv[k_], dst_ + k_ * 64); }
        __syncthreads();
    }
}

__device__ __forceinline__ void attn_phase(const Params& p) {
    const int tid = tid_opaque(), lane = tid & 63, wave = tid >> 6, fr = lane & 15, fq = lane >> 4;
    const int gw = blockIdx.x * NWAVES + wave, NGW = gridDim.x * NWAVES;
    unsigned char* ws = p.ws;
    const bf16_t *QP = (const bf16_t*)(ws + WS_QP), *QS = (const bf16_t*)(ws + WS_QS), *KPP = (const bf16_t*)(ws + WS_KPP), *VTP = (const bf16_t*)(ws + WS_VTP), *KPS = (const bf16_t*)(ws + WS_KPS), *VTS = (const bf16_t*)(ws + WS_VTS);
    float* OBR = (float*)(ws + WS_OBR); float* LSE = (float*)(ws + WS_LSE);
    constexpr int NP = 2 * 24 * 512, NS = 32 * 104;
    for (int item = gw; item < NP + NS; item += NGW) {
        int is_s, b, head, r, mq0, nqv;
        if (item < NP) { is_s = 0; b = item / 12288; const int rem = item % 12288; head = rem >> 9; const int wt = rem & 511; const int sh = 2 * (head >> 3), per = 512 >> sh; r = wt / per; mq0 = 16 * (wt % per); nqv = 16; }
        else { const int si = item - NP; is_s = 1; b = si / 104; const int rem = si % 104;
            if (rem < 8) { head = rem; r = 0; mq0 = 2048; nqv = 8; }
            else if (rem < 40) { const int x = rem - 8; head = 8 + (x >> 2); r = x & 3; mq0 = 512; nqv = 2; }
            else { const int x = rem - 40; head = 16 + (x >> 3); r = x & 7; mq0 = 128; nqv = 1; } }
        const int sh = 2 * (head >> 3);
        const int Lr = is_s ? (2048 >> sh) + 8 : (8192 >> sh);
        const bf16_t* Kb = (is_s ? KPS + ((size_t)b * 24 + head) * SROWS * 64 : KPP + ((size_t)b * 24 + head) * 8192 * 64) + (size_t)r * Lr * 64;
        const bf16_t* Vb = (is_s ? VTS + ((size_t)b * 24 + head) * (64 * SROWS) : VTP + ((size_t)b * 24 + head) * (64 * 8192)) + (size_t)r * 64 * Lr;
        const int qi = fr < nqv ? fr : nqv - 1;
        const bf16_t* Qrow = is_s ? QS + (((size_t)b * 24 + head) * 8 + r * nqv + qi) * 64 : QP + (((size_t)b * 24 + head) * 8192 + (size_t)r * Lr + mq0 + qi) * 64;
        const bf16x8 q0 = *(const bf16x8*)(Qrow + 8 * fq), q1 = *(const bf16x8*)(Qrow + 32 + 8 * fq);
        const int mk0 = mq0 - 128;
        f32x4 s[9];
#pragma unroll
        for (int blk = 0; blk < 9; ++blk) { int mj = mk0 + 16 * blk + fr; mj = mj < 0 ? 0 : (mj > Lr - 1 ? Lr - 1 : mj);
            const bf16_t* kr = Kb + (size_t)mj * 64 + 8 * fq; const bf16x8 k0 = *(const bf16x8*)kr, k1 = *(const bf16x8*)(kr + 32);
            f32x4 a = {0.f, 0.f, 0.f, 0.f}; a = __builtin_amdgcn_mfma_f32_16x16x32_bf16(k0, q0, a, 0, 0, 0); s[blk] = __builtin_amdgcn_mfma_f32_16x16x32_bf16(k1, q1, a, 0, 0, 0); }
        float mx = -3.0e38f;
#pragma unroll
        for (int blk = 0; blk < 9; ++blk)
#pragma unroll
            for (int e = 0; e < 4; ++e) { const int j = 16 * blk + 4 * fq + e; const bool ok = (j >= fr) && (j <= fr + 128) && (mk0 + j >= 0);
                const float v = ok ? s[blk][e] : -1.0e30f; s[blk][e] = v; mx = fmaxf(mx, v); }
        mx = fmaxf(mx, __shfl_xor(mx, 16)); mx = fmaxf(mx, __shfl_xor(mx, 32));
        float l = 0.f;
#pragma unroll
        for (int blk = 0; blk < 9; ++blk)
#pragma unroll
            for (int e = 0; e < 4; ++e) { const float pe = __expf(s[blk][e] - mx); l += pe; s[blk][e] = pe; }
        l += __shfl_xor(l, 16); l += __shfl_xor(l, 32);
        f32x4 o[4];
#pragma unroll
        for (int db = 0; db < 4; ++db) o[db] = (f32x4){0.f, 0.f, 0.f, 0.f};
#pragma unroll
        for (int pr = 0; pr < 5; ++pr) {
            u32x4 pw; pw.x = cvt_pk_bf16(s[2 * pr][0], s[2 * pr][1]); pw.y = cvt_pk_bf16(s[2 * pr][2], s[2 * pr][3]);
            if (pr < 4) { pw.z = cvt_pk_bf16(s[2 * pr + 1][0], s[2 * pr + 1][1]); pw.w = cvt_pk_bf16(s[2 * pr + 1][2], s[2 * pr + 1][3]); } else { pw.z = 0u; pw.w = 0u; }
            const bf16x8 pf = __builtin_bit_cast(bf16x8, pw);
            int ma = mk0 + 32 * pr + 4 * fq, mb = ma + 16;
            ma = ma < 0 ? 0 : (ma > Lr - 4 ? Lr - 4 : ma); mb = mb < 0 ? 0 : (mb > Lr - 4 ? Lr - 4 : mb);
#pragma unroll
            for (int db = 0; db < 4; ++db) { const bf16_t* vr = Vb + (size_t)(16 * db + fr) * Lr;
                const u32x2 va = *(const u32x2*)(vr + ma), vb = *(const u32x2*)(vr + mb);
                u32x4 vw; vw.x = va.x; vw.y = va.y; vw.z = vb.x; vw.w = vb.y;
                o[db] = __builtin_amdgcn_mfma_f32_16x16x32_bf16(__builtin_bit_cast(bf16x8, vw), pf, o[db], 0, 0, 0); }
        }
        if (fr < nqv) {
            const int pq = ((mq0 + fr) << sh) + r;
            const int token = is_s ? T_P + b * 8 + (pq - 2048) : b * 8192 + pq;
            const float inv = 1.f / l;
#pragma unroll
            for (int db = 0; db < 4; ++db) *(f32x4*)(OBR + (size_t)token * AW + head * 64 + 16 * db + 4 * fq) = o[db] * inv;
            if (fq == 0) LSE[(size_t)token * 24 + head] = mx + logf(l);
        }
    }
}

__device__ __forceinline__ void merge_phase(const Params& p) {
    const size_t gt = (size_t)blockIdx.x * NTHREADS + tid_opaque(), NT = (size_t)gridDim.x * NTHREADS;
    const float* OBR = (const float*)(p.ws + WS_OBR); const float* LSE = (const float*)(p.ws + WS_LSE); bf16_t* OB = (bf16_t*)(p.ws + WS_OB);
    for (size_t i = gt; i < (size_t)MT * 64; i += NT) { const size_t token = i >> 6; const int h = (int)((i >> 3) & 7), ch = (int)(i & 7);
        const float l0 = LSE[token * 24 + h], l1 = LSE[token * 24 + 8 + h], l2 = LSE[token * 24 + 16 + h];
        const float mx = fmaxf(l0, fmaxf(l1, l2)); float w0 = __expf(l0 - mx), w1 = __expf(l1 - mx), w2 = __expf(l2 - mx); const float inv = 1.f / (w0 + w1 + w2); w0 *= inv; w1 *= inv; w2 *= inv;
        const float* o0 = OBR + token * AW + h * 64 + ch * 8;
        const f32x4 a0 = *(const f32x4*)o0, b0 = *(const f32x4*)(o0 + 4), a1 = *(const f32x4*)(o0 + 512), b1 = *(const f32x4*)(o0 + 516), a2 = *(const f32x4*)(o0 + 1024), b2 = *(const f32x4*)(o0 + 1028);
        const f32x4 a = a0 * w0 + a1 * w1 + a2 * w2, bb = b0 * w0 + b1 * w1 + b2 * w2;
        u32x4 w; w.x = cvt_pk_bf16(a.x, a.y); w.y = cvt_pk_bf16(a.z, a.w); w.z = cvt_pk_bf16(bb.x, bb.y); w.w = cvt_pk_bf16(bb.z, bb.w);
        *(u32x4*)(OB + token * MW + h * 64 + ch * 8) = w; }
}

__device__ __forceinline__ void final_phase(const Params& p) {
    const int lane = tid_opaque() & 63, wave = tid_opaque() >> 6;
    const int gw = blockIdx.x * NWAVES + wave, NGW = gridDim.x * NWAVES;
    const float* X = (const float*)(p.ws + WS_X); const float* ss6 = (const float*)(p.ws + WS_SS) + (size_t)6 * MT;
    for (int row = gw; row < MT; row += NGW) { const float rs = rs_of(ss6[row]);
        float* dst = row < T_P ? p.out + O_YP + (size_t)row * DM : p.out + O_YS + (size_t)(row - T_P) * DM;
#pragma unroll
        for (int j = 0; j < 4; ++j) { const f32x4 v = ((const f32x4*)(X + (size_t)row * DM))[lane + 64 * j], g = ((const f32x4*)p.final_norm)[lane + 64 * j]; ((f32x4*)dst)[lane + 64 * j] = v * rs * g; }
    }
}


__device__ __forceinline__ void ctr_barrier(unsigned* cnt, unsigned target) {
    asm volatile("s_waitcnt vmcnt(0)" ::: "memory");
    __syncthreads();
    if (threadIdx.x == 0) {
        __builtin_amdgcn_fence(__ATOMIC_RELEASE, "agent");
        asm volatile("s_waitcnt vmcnt(0)" ::: "memory");
        __hip_atomic_fetch_add(cnt, 1u, __ATOMIC_RELAXED, __HIP_MEMORY_SCOPE_AGENT);
        unsigned sp = 0;
        while (__hip_atomic_load(cnt, __ATOMIC_RELAXED, __HIP_MEMORY_SCOPE_AGENT) < target) { __builtin_amdgcn_s_sleep(1); if (++sp > (1u << 24)) break; }
        __builtin_amdgcn_fence(__ATOMIC_ACQUIRE, "agent");
        asm volatile("s_waitcnt vmcnt(0)" ::: "memory");
    }
    __syncthreads();
}
__global__ void __launch_bounds__(NTHREADS, 2) yoco_fwd(Params p) {
    extern __shared__ __attribute__((aligned(16))) unsigned char shm[];
    LAS unsigned char* lds = (LAS unsigned char*)shm;
    cg::grid_group grid = cg::this_grid();
    unsigned char* ws = p.ws;
    float* X = (float*)(ws + WS_X); bf16_t* Xb = (bf16_t*)(ws + WS_XB); bf16_t* H = (bf16_t*)(ws + WS_H); bf16_t* Z = (bf16_t*)(ws + WS_Z); float* SS = (float*)(ws + WS_SS);
    const float* rope = (const float*)(ws + WS_ROPE);

    phase0(p, lds);
    grid.sync();
    unsigned* gbar = (unsigned*)(ws + WS_BAR);
    { EpiSwiGLU e; e.H = H; e.ss = SS; run_gemm(lds, Xb, (const bf16_t*)(ws + WS_W1IN), 2 * FF, DM, e); }
    ctr_barrier(gbar, 1u * gridDim.x);
    { EpiResid e; e.X = X; e.Xb = Xb; e.ss_out = SS + MT; e.scale = 0.5f; run_gemm(lds, H, (const bf16_t*)(ws + WS_W1OUT), DM, FF, e); }
    ctr_barrier(gbar, 2u * gridDim.x);
    s5_pass<false>(p, lds);
    ctr_barrier(gbar, 3u * gridDim.x);
    s5_pass<true>(p, lds);
    ctr_barrier(gbar, 4u * gridDim.x);
    { EpiGLU e; e.X = X; e.Xb = Xb; e.ss_out = SS + 2 * MT; run_gemm(lds, Z, (const bf16_t*)(ws + WS_WGLU), 2048, DM, e); }
    ctr_barrier(gbar, 5u * gridDim.x);
    { EpiSwiGLU e; e.H = H; e.ss = SS + 2 * MT; run_gemm(lds, Xb, (const bf16_t*)(ws + WS_W2IN), 2 * FF, DM, e); }
    ctr_barrier(gbar, 6u * gridDim.x);
    { EpiResid e; e.X = X; e.Xb = Xb; e.ss_out = SS + 3 * MT; e.scale = 0.5f; run_gemm(lds, H, (const bf16_t*)(ws + WS_W2OUT), DM, FF, e); }
    ctr_barrier(gbar, 7u * gridDim.x);
    { EpiKV e; e.ss = SS + 3 * MT; e.rope = rope; e.out = p.out; e.KPP = (bf16_t*)(ws + WS_KPP); e.VTP = (bf16_t*)(ws + WS_VTP); e.KPS = (bf16_t*)(ws + WS_KPS); e.VTS = (bf16_t*)(ws + WS_VTS);
      run_gemm(lds, Xb, (const bf16_t*)(ws + WS_WKV), 3072, DM, e); }
    { EpiSwiGLU e; e.H = H; e.ss = SS + 3 * MT; run_gemm(lds, Xb, (const bf16_t*)(ws + WS_W1IN + W_IN_B), 2 * FF, DM, e); }
    ctr_barrier(gbar, 8u * gridDim.x);
    { EpiResid e; e.X = X; e.Xb = Xb; e.ss_out = SS + 4 * MT; e.scale = 0.5f; run_gemm(lds, H, (const bf16_t*)(ws + WS_W1OUT + W_OUT_B), DM, FF, e); }
    ctr_barrier(gbar, 9u * gridDim.x);
    { EpiQ e; e.ss = SS + 4 * MT; e.rope = rope; e.QP = (bf16_t*)(ws + WS_QP); e.QS = (bf16_t*)(ws + WS_QS); run_gemm(lds, Xb, (const bf16_t*)(ws + WS_WQ), 1536, DM, e); }
    ctr_barrier(gbar, 10u * gridDim.x);
    attn_phase(p);
    ctr_barrier(gbar, 11u * gridDim.x);
    merge_phase(p);
    ctr_barrier(gbar, 12u * gridDim.x);
    { EpiResid e; e.X = X; e.Xb = Xb; e.ss_out = SS + 5 * MT; e.scale = 1.0f; run_gemm(lds, (const bf16_t*)(ws + WS_OB), (const bf16_t*)(ws + WS_WO), DM, MW, e); }
    ctr_barrier(gbar, 13u * gridDim.x);
    { EpiSwiGLU e; e.H = H; e.ss = SS + 5 * MT; run_gemm(lds, Xb, (const bf16_t*)(ws + WS_W2IN + W_IN_B), 2 * FF, DM, e); }
    ctr_barrier(gbar, 14u * gridDim.x);
    { EpiResid e; e.X = X; e.Xb = Xb; e.ss_out = SS + 6 * MT; e.scale = 0.5f; run_gemm(lds, H, (const bf16_t*)(ws + WS_W2OUT + W_OUT_B), DM, FF, e); }
    ctr_barrier(gbar, 15u * gridDim.x);
    final_phase(p);
}

extern "C" void kernel_launch(void* const* d_in, const int* in_sizes, int n_in, void* d_out, int out_size, void* d_ws, size_t ws_size, hipStream_t stream) {
    static int grid_blocks = 0;
    if (grid_blocks == 0) {
        if (n_in != 26 || (size_t)out_size != O_END || ws_size < WS_END) { fprintf(stderr, "kernel_launch: unexpected shapes (n_in %d, out %d, ws %zu; need ws >= %zu)\n", n_in, out_size, ws_size, (size_t)WS_END); grid_blocks = -1; return; }
        int dev = 0, cus = 0, per_cu = 0;
        hipGetDevice(&dev);
        hipDeviceGetAttribute(&cus, hipDeviceAttributeMultiprocessorCount, dev);
        if (hipFuncSetAttribute((const void*)yoco_fwd, hipFuncAttributeMaxDynamicSharedMemorySize, LDS_BYTES) != hipSuccess) { fprintf(stderr, "kernel_launch: hipFuncSetAttribute failed\n"); grid_blocks = -1; return; }
        if (hipOccupancyMaxActiveBlocksPerMultiprocessor(&per_cu, (const void*)yoco_fwd, NTHREADS, LDS_BYTES) != hipSuccess || per_cu < 1) { fprintf(stderr, "kernel_launch: occupancy query failed (%d)\n", per_cu); per_cu = 1; (void)hipGetLastError(); }
        if (per_cu > 1) per_cu = 1;
        grid_blocks = cus * per_cu;
    }
    if (grid_blocks < 0) return;
    Params p{};
    const float** f = (const float**)&p;
    for (int i = 0; i < 26; ++i) f[i] = (const float*)d_in[i];
    p.out = (float*)d_out; p.ws = (unsigned char*)d_ws;
    void* args[] = {&p};
    (void)hipMemsetAsync((unsigned char*)d_ws + WS_BAR, 0, 256, stream);
    hipError_t e = hipLaunchCooperativeKernel((const void*)yoco_fwd, dim3(grid_blocks), dim3(NTHREADS), args, LDS_BYTES, stream);
    if (e != hipSuccess) fprintf(stderr, "cooperative launch failed: %s (grid %d)\n", hipGetErrorString(e), grid_blocks);
}
```

```cpp
#include <hip/hip_runtime.h>
#include <hip/hip_cooperative_groups.h>
#include <cstdio>
#include <cstdint>
namespace cg = cooperative_groups;
namespace pg8 {
#define PG8_LAS __attribute__((address_space(3)))
typedef unsigned short bf16_t;
typedef short bf16x8 __attribute__((ext_vector_type(8)));
typedef float f32x4 __attribute__((ext_vector_type(4)));
typedef unsigned u32x4 __attribute__((ext_vector_type(4)));
constexpr int BM = 256, BK = 64, HALF = 128, HTB = HALF * BK * 2  , STAGE_BYTES = 8 * HTB, NXCD = 8, WGM = 8;

__host__ __device__ __forceinline__ int lds_byte(int r, int c) { const int st = (r >> 4) * 2 + (c >> 5), rr = r & 15, cc = c & 31, ob = rr * 64 + cc * 2; return st * 1024 + (ob ^ (((ob >> 9) & 1) << 5)); }
__host__ __device__ __forceinline__ void stage_rc(int b, int& R, int& C) { const int st = b / 1024, sb = b % 1024, swz = sb ^ (((sb >> 9) & 1) << 5); R = (st >> 1) * 16 + swz / 64; C = (st & 1) * 32 + (swz % 64) / 2; }
__host__ __device__ __forceinline__ int perm32(int rho) { const int n = rho >> 4, i = rho & 15; return 8 * (i >> 2) + 4 * n + (i & 3); }

struct Unit { int pm, pn; };
struct Gemm { const bf16_t* A; const bf16_t* Bt; int M, N, K; };

struct StaticOrder {
    int nM, nN, nwg, G, c;
    __host__ __device__ void init(int M, int N, int G_, int c_) { nM = M / BM; nN = N / BM; nwg = nM * nN; G = G_; c = c_; }
    __host__ __device__ bool next(int i, Unit& u) const {
        const long L = (long)i * G + c; if (L >= nwg) return false;
        int wgid = (int)L; { const int q = nwg / NXCD, r = nwg % NXCD, xcd = wgid % NXCD, off = wgid / NXCD; wgid = (xcd < r ? xcd * (q + 1) : r * (q + 1) + (xcd - r) * q) + off; }
        const int nig = WGM * nN, gid = wgid / nig, fm = gid * WGM, gsz = (nM - fm) < WGM ? (nM - fm) : WGM;
        u.pm = fm + ((wgid % nig) % gsz); u.pn = (wgid % nig) / gsz; return true;
    }
    __device__ __forceinline__ void a_ready(const Unit&) const {}
    __device__ __forceinline__ void done(const Unit&) const {}
};
__device__ __forceinline__ unsigned cvt_pk_bf16(float lo, float hi) { unsigned r; asm volatile("v_cvt_pk_bf16_f32 %0, %1, %2" : "=v"(r) : "v"(lo), "v"(hi)); return r; }
template <class Epi, class Sched, bool STAMP = false>
__device__ __forceinline__ void gemm_phase(PG8_LAS unsigned char* lds, const Gemm g, const Sched& S, const Epi& E, unsigned long long* stamps) {
    int tid_ = threadIdx.x; asm volatile("" : "+v"(tid_));
    const int tid = tid_, wid = __builtin_amdgcn_readfirstlane(tid >> 6), lane = tid & 63, wr = wid >> 2, wc = wid & 3, fr = lane & 15, fq = lane >> 4;
    const int K = g.K, nt = K / BK;
    int ts_lo = 0, ts_hi = 0, nts = 0; const unsigned long long rt_entry = STAMP ? (unsigned long long)wall_clock64() : 0ull;
#define PG8_STAMP() do { if (STAMP && wid == 0 && nts < 64) { const unsigned long long _c = (unsigned long long)clock64(); \
        ts_lo = (lane == nts) ? (int)(unsigned)_c : ts_lo; ts_hi = (lane == nts) ? (int)(unsigned)(_c >> 32) : ts_hi; ++nts; } } while (0)
    PG8_STAMP();
    unsigned voffA[2], voffB[2];
#pragma unroll
    for (int i = 0; i < 2; ++i) { int R, C; stage_rc(tid * 16 + i * 8192, R, C); const int Rb = Epi::PERM ? ((R & ~31) + perm32(R & 31)) : R;
        voffA[i] = (unsigned)(R * K + C) * 2u; voffB[i] = (unsigned)(Rb * K + C) * 2u; }
    const size_t kstep = (size_t)(BK * 2);
    const size_t hstep = (size_t)HALF * K * 2;
    const size_t tstep = 2 * hstep;
    const unsigned ldsw = (unsigned)wid * 1024u;
    const int aoff = lds_byte(wr * 64 + fr, fq * 8), boff = lds_byte(wc * 32 + fr, fq * 8);
#define PG8_SA(b, h) (((b) * 2 + (h)) * HTB)
#define PG8_SB(b, h) ((4 + (b) * 2 + (h)) * HTB)
#define PG8_STAGE(bufoff, gbase, voff) do { _Pragma("unroll") for (int _i = 0; _i < 2; ++_i) \
        __builtin_amdgcn_global_load_lds((const unsigned*)((const char*)(gbase) + (voff)[_i]), (PG8_LAS unsigned*)(lds + (bufoff) + ldsw + _i * 8192), 16, 0, 0); } while (0)
#define PG8_LDA(dst, b, h) do { _Pragma("unroll") for (int m = 0; m < 4; ++m) _Pragma("unroll") for (int k = 0; k < 2; ++k) dst[m][k] = *(const PG8_LAS bf16x8*)(lds + PG8_SA(b, h) + aoff + m * 2048 + k * 1024); } while (0)
#define PG8_LDB(dst, b, h) do { _Pragma("unroll") for (int n = 0; n < 2; ++n) _Pragma("unroll") for (int k = 0; k < 2; ++k) dst[n][k] = *(const PG8_LAS bf16x8*)(lds + PG8_SB(b, h) + boff + n * 2048 + k * 1024); } while (0)
#define PG8_MMA(ai, bj, At, Bt) do { __builtin_amdgcn_s_setprio(1); _Pragma("unroll") for (int m = 0; m < 4; ++m) _Pragma("unroll") for (int n = 0; n < 2; ++n) _Pragma("unroll") for (int k = 0; k < 2; ++k) \
        acc[ai][bj][m][n] = __builtin_amdgcn_mfma_f32_16x16x32_bf16(Bt[n][k], At[m][k], acc[ai][bj][m][n], 0, 0, 0); __builtin_amdgcn_s_setprio(0); } while (0)
#define PG8_WAIT_V(n) asm volatile("s_waitcnt vmcnt(" #n ")" ::: "memory")
#define PG8_WAIT_L(n) asm volatile("s_waitcnt lgkmcnt(" #n ")" ::: "memory")
#define PG8_BAR __builtin_amdgcn_s_barrier()
#define PG8_SCHED __builtin_amdgcn_sched_barrier(0)
    Unit cur, nxt; int ui = 0;
    if (!S.next(0, cur)) return;
    f32x4 acc[2][2][4][2];
#pragma unroll
    for (int a = 0; a < 2; ++a)
#pragma unroll
        for (int b = 0; b < 2; ++b)
#pragma unroll
            for (int m = 0; m < 4; ++m)
#pragma unroll
                for (int n = 0; n < 2; ++n) acc[a][b][m][n] = (f32x4){0.f, 0.f, 0.f, 0.f};
    bf16x8 At[4][2], B0[2][2], B1[2][2];
    const char* cA = (const char*)g.A + (size_t)cur.pm * tstep; const char* cB = (const char*)g.Bt + (size_t)cur.pn * tstep;
    S.a_ready(cur);
    PG8_STAGE(PG8_SB(0, 0), cB, voffB); PG8_STAGE(PG8_SA(0, 0), cA, voffA); PG8_STAGE(PG8_SB(0, 1), cB + hstep, voffB); PG8_STAGE(PG8_SA(0, 1), cA + hstep, voffA);
    if (wr == 1) PG8_BAR;
    PG8_WAIT_V(4); PG8_BAR;
    PG8_STAGE(PG8_SB(1, 0), cB + kstep, voffB); PG8_STAGE(PG8_SA(1, 0), cA + kstep, voffA); PG8_STAGE(PG8_SB(1, 1), cB + hstep + kstep, voffB);
    PG8_WAIT_V(6); PG8_BAR;
    PG8_STAMP();
    for (;;) {
        const bool has_next = S.next(ui + 1, nxt);
        const char* nA = has_next ? (const char*)g.A + (size_t)nxt.pm * tstep : cA; const char* nB = has_next ? (const char*)g.Bt + (size_t)nxt.pn * tstep : cB;
        for (int t = 0; t < nt; t += 2) {
            const bool last = (t == nt - 2);
            const char* a1 = cA + (size_t)(t + 1) * kstep;
            const char* a2 = last ? nA : cA + (size_t)(t + 2) * kstep; const char* b2 = last ? nB : cB + (size_t)(t + 2) * kstep;
            const char* a3 = a2 + kstep; const char* b3 = b2 + kstep;
            if (last && has_next) S.a_ready(nxt);
            PG8_LDB(B0, 0, 0); PG8_SCHED; PG8_LDA(At, 0, 0); PG8_STAGE(PG8_SA(1, 1), a1 + hstep, voffA);
            PG8_WAIT_L(8); PG8_BAR; PG8_WAIT_L(0); PG8_MMA(0, 0, At, B0); PG8_BAR; PG8_SCHED;
            PG8_LDB(B1, 0, 1); PG8_STAGE(PG8_SB(0, 0), b2, voffB);
            PG8_BAR; PG8_WAIT_L(0); PG8_MMA(0, 1, At, B1); PG8_BAR;
            PG8_LDA(At, 0, 1); PG8_STAGE(PG8_SA(0, 0), a2, voffA);
            PG8_BAR; PG8_WAIT_L(0); PG8_MMA(1, 0, At, B0); PG8_BAR; PG8_SCHED;
            PG8_STAGE(PG8_SB(0, 1), b2 + hstep, voffB);
            PG8_WAIT_V(6); PG8_BAR; PG8_MMA(1, 1, At, B1); PG8_BAR;
            PG8_LDB(B0, 1, 0); PG8_SCHED; PG8_LDA(At, 1, 0); PG8_STAGE(PG8_SA(0, 1), a2 + hstep, voffA);
            PG8_WAIT_L(8); PG8_BAR; PG8_WAIT_L(0); PG8_MMA(0, 0, At, B0); PG8_BAR; PG8_SCHED;
            PG8_LDB(B1, 1, 1); PG8_STAGE(PG8_SB(1, 0), b3, voffB);
            PG8_BAR; PG8_WAIT_L(0); PG8_MMA(0, 1, At, B1); PG8_BAR;
            PG8_LDA(At, 1, 1); PG8_STAGE(PG8_SA(1, 0), a3, voffA);
            PG8_BAR; PG8_WAIT_L(0); PG8_MMA(1, 0, At, B0); PG8_BAR; PG8_SCHED;
            PG8_STAGE(PG8_SB(1, 1), b3 + hstep, voffB);
            PG8_WAIT_V(6); PG8_BAR; PG8_MMA(1, 1, At, B1); PG8_BAR;
        }
        PG8_STAMP();
        if constexpr (!Epi::AFTER_DRAIN) { E(acc, cur, wr, wc, fr, fq); S.done(cur); }
        PG8_STAMP();
        if (!has_next) break;
#pragma unroll
        for (int a = 0; a < 2; ++a)
#pragma unroll
            for (int b = 0; b < 2; ++b)
#pragma unroll
                for (int m = 0; m < 4; ++m)
#pragma unroll
                    for (int n = 0; n < 2; ++n) acc[a][b][m][n] = (f32x4){0.f, 0.f, 0.f, 0.f};
        cur = nxt; cA = nA; cB = nB; ++ui;
    }
    PG8_WAIT_V(0);
    if (wr == 0) PG8_BAR;
    PG8_BAR;
    if constexpr (Epi::AFTER_DRAIN) { E.fused(acc, cur, wr, wc, fr, fq, lds, wid, lane); S.done(cur); }
    PG8_STAMP();
    if (STAMP && wid == 0) { stamps[lane] = lane < nts ? (((unsigned long long)(unsigned)ts_hi << 32) | (unsigned)ts_lo) : 0ull;
        if (lane == 62) stamps[62] = rt_entry; if (lane == 63) stamps[63] = (unsigned long long)wall_clock64(); }
#undef PG8_STAMP
#undef PG8_SA
#undef PG8_SB
#undef PG8_STAGE
#undef PG8_LDA
#undef PG8_LDB
#undef PG8_MMA
#undef PG8_WAIT_V
#undef PG8_WAIT_L
#undef PG8_BAR
#undef PG8_SCHED
}
}

#define LAS __attribute__((address_space(3)))
using pg8::bf16_t; using pg8::bf16x8; using pg8::f32x4; using pg8::u32x4; using pg8::cvt_pk_bf16;
typedef unsigned u32x2 __attribute__((ext_vector_type(2)));

constexpr int DM = 1024, T_P = 16384, T_S = 256, MT = T_P + T_S, FF = 2816, NH = 24, AW = 1536, MW = 512;
constexpr int SROWS = 2176;
constexpr float RMS_EPS = 1e-6f;
constexpr int NTHREADS = 512, NWAVES = 8;
constexpr int LDS_BYTES = 131072;

constexpr size_t O_YP = 0, O_YS = 16777216, O_SSP = O_YS + 262144, O_CKP = O_SSP + 16384, O_CVP = O_CKP + 6291456,
                 O_SSS = O_CVP + 6291456, O_CKS = O_SSS + 262144, O_CVS = O_CKS + 100663296, O_END = O_CVS + 100663296;

constexpr size_t al256(size_t x) { return (x + 255) & ~(size_t)255; }
constexpr size_t W_IN_B = (size_t)2 * FF * DM * 2, W_OUT_B = (size_t)DM * FF * 2;
constexpr size_t WS_W1IN = 0;
constexpr size_t WS_W2IN = WS_W1IN + 2 * W_IN_B;
constexpr size_t WS_W1OUT = WS_W2IN + 2 * W_IN_B;
constexpr size_t WS_W2OUT = WS_W1OUT + 2 * W_OUT_B;
constexpr size_t WS_WGLU = WS_W2OUT + 2 * W_OUT_B;
constexpr size_t WS_WKV = WS_WGLU + (size_t)2048 * 1024 * 2;
constexpr size_t WS_WQ = WS_WKV + (size_t)3072 * 1024 * 2;
constexpr size_t WS_WO = WS_WQ + (size_t)1536 * 1024 * 2;
constexpr size_t WS_X = WS_WO + (size_t)1024 * 512 * 2;
constexpr size_t WS_XB = WS_X + (size_t)MT * DM * 4;
constexpr size_t WS_H = WS_XB + (size_t)MT * DM * 2;
constexpr size_t WS_Z = WS_H + (size_t)MT * FF * 2;
constexpr size_t WS_SS = WS_Z + (size_t)MT * DM * 2;
constexpr size_t WS_ROPE = al256(WS_SS + (size_t)7 * MT * 4);
constexpr size_t WS_LAM = WS_ROPE + (size_t)MT * 16 * 4;
constexpr size_t WS_LAM64 = WS_LAM + 4096 * 8;
constexpr size_t WS_BRE = WS_LAM64 + 4096 * 8;
constexpr size_t WS_BIM = WS_BRE + 4096 * 64;
constexpr size_t WS_CPK = WS_BIM + 4096 * 64;
constexpr size_t WS_SLOC = WS_CPK + (size_t)64 * 16 * 128 * 2;
constexpr size_t WS_QP = WS_SLOC + (size_t)2 * 128 * 4096 * 8;
constexpr size_t WS_QS = WS_QP + (size_t)2 * 24 * 8192 * 64 * 2;
constexpr size_t WS_KPP = WS_QS + (size_t)32 * 24 * 8 * 64 * 2;
constexpr size_t WS_VTP = WS_KPP + (size_t)2 * 24 * 8192 * 64 * 2;
constexpr size_t WS_KPS = WS_VTP + (size_t)2 * 24 * 8192 * 64 * 2;
constexpr size_t WS_VTS = WS_KPS + (size_t)32 * 24 * SROWS * 64 * 2;
constexpr size_t WS_OBR = WS_VTS + (size_t)32 * 24 * SROWS * 64 * 2;
constexpr size_t WS_LSE = WS_OBR + (size_t)MT * AW * 4;
constexpr size_t WS_OB = al256(WS_LSE + (size_t)MT * 24 * 4);
constexpr size_t WS_BAR = al256(WS_OB + (size_t)MT * MW * 2);
constexpr size_t WS_END = WS_BAR + 512;

struct Params {
    const float *x_prompt, *x_sample, *state_ssm, *cache_k, *cache_v;
    const float *ffn_norm1, *ffn_w1_in, *ffn_w1_out, *ffn_norm2, *ffn_w2_in, *ffn_w2_out, *mix_norm;
    const float *a_re, *a_im, *log_dt, *b_re, *b_im, *c_re, *c_im, *ssm_d, *w_glu;
    const float *kv_norm, *w_kv, *w_q, *w_o, *final_norm;
    float* out;
    unsigned char* ws;
};

__device__ __forceinline__ int tid_opaque() { int t = threadIdx.x; asm volatile("" : "+v"(t)); return t; }
constexpr int CPB = (2040 * 1536 / 4) / 512, NCU_ALL = 64 * CPB;
constexpr int NCU_S5A = 2048 * 8, NCU_S5B = 2304 * 8, NCU0 = NCU_ALL - NCU_S5A - NCU_S5B;
__device__ __forceinline__ float wave_sum(float v) {
#pragma unroll
    for (int o = 1; o < 64; o <<= 1) v += __shfl_xor(v, o);
    return v;
}
__device__ __forceinline__ bf16_t f2bf(float f) { return (bf16_t)(cvt_pk_bf16(f, 0.f) & 0xffffu); }
__device__ __forceinline__ float rs_of(float ss) { return rsqrtf(ss * (1.0f / DM) + RMS_EPS); }
#define LDS_FENCE() asm volatile("s_waitcnt lgkmcnt(0)" ::: "memory")

__device__ __forceinline__ void dsincos(double a, double& s, double& c) {
    const double k = rint(a * 0.63661977236758134308);
    double r = fma(-k, 1.5707963267948966, a); r = fma(-k, 6.123233995736766e-17, r);
    const int q = (int)(((long long)k) & 3);
    const double r2 = r * r;
    const double sr = r * (1.0 + r2 * (-1.0 / 6 + r2 * (1.0 / 120 + r2 * (-1.0 / 5040 + r2 * (1.0 / 362880 + r2 * (-1.0 / 39916800 + r2 * (1.0 / 6227020800.0 + r2 * (-1.0 / 1307674368000.0))))))));
    const double cr = 1.0 + r2 * (-0.5 + r2 * (1.0 / 24 + r2 * (-1.0 / 720 + r2 * (1.0 / 40320 + r2 * (-1.0 / 3628800 + r2 * (1.0 / 479001600.0 + r2 * (-1.0 / 87178291200.0 + r2 * (1.0 / 20922789888000.0))))))));
    s = (q == 0) ? sr : (q == 1) ? cr : (q == 2) ? -sr : -cr;
    c = (q == 0) ? cr : (q == 1) ? -sr : (q == 2) ? -cr : sr;
}

__device__ __forceinline__ void tok_info(int row, int& is_s, int& b, int& pos) {
    if (row < T_P) { is_s = 0; b = row >> 13; pos = row & 8191; } else { const int rr = row - T_P; is_s = 1; b = rr >> 3; pos = 2048 + (rr & 7); }
}

__device__ __forceinline__ void wt_item(const float* W, int K, int N, bf16_t* WT, const float* gain, int Nh, LAS float* scr, int item, int lane) {
    const int nblk = N / 32, kb = item / nblk, nb = item % nblk, k0 = 64 * kb, n0 = 32 * nb;
    const int c0 = Nh ? (((n0 >> 7) & 1) * Nh + (n0 >> 8) * 128 + (n0 & 127)) : n0;
    float wv[32];
#pragma unroll
    for (int i = 0; i < 32; ++i) { const int kk = 2 * i + (lane >> 5); wv[i] = W[(size_t)(k0 + kk) * N + c0 + (lane & 31)]; }
#pragma unroll
    for (int i = 0; i < 32; ++i) { const int kk = 2 * i + (lane >> 5); float v = wv[i]; if (gain) v *= gain[k0 + kk]; scr[kk * 33 + (lane & 31)] = v; }
    LDS_FENCE();
    const int c = lane & 7;
#pragma unroll
    for (int j = 0; j < 4; ++j) { const int n = (lane >> 3) + 8 * j; const LAS float* s = scr + (8 * c) * 33 + n;
        u32x4 o; o.x = cvt_pk_bf16(s[0 * 33], s[1 * 33]); o.y = cvt_pk_bf16(s[2 * 33], s[3 * 33]); o.z = cvt_pk_bf16(s[4 * 33], s[5 * 33]); o.w = cvt_pk_bf16(s[6 * 33], s[7 * 33]);
        *(u32x4*)(WT + (size_t)(n0 + n) * K + k0 + 8 * c) = o; }
    LDS_FENCE();
}

__device__ __forceinline__ void phase0(const Params& p, LAS unsigned char* lds) {
    const int tid = tid_opaque(), lane = tid & 63, wave = tid >> 6;
    const int gw = blockIdx.x * NWAVES + wave, NGW = gridDim.x * NWAVES;
    const size_t gt = (size_t)blockIdx.x * NTHREADS + tid, NT = (size_t)gridDim.x * NTHREADS;
    unsigned char* ws = p.ws;
    LAS float* scr = (LAS float*)(lds + wave * 8448);
    constexpr int NCU = NCU0;
    int cu = gw;
#define CP_ISSUE(V, OK, UN) do { OK = (UN) < NCU; if (OK) { const int seg_ = (UN) / CPB, chn_ = (UN) % CPB, kv_ = seg_ >> 5, b_ = seg_ & 31; \
        const f32x4* src_ = (const f32x4*)((kv_ ? p.cache_v : p.cache_k) + (size_t)b_ * (2048 * 1536) + 8 * 1536) + chn_ * 512 + lane; \
        _Pragma("unroll") for (int k_ = 0; k_ < 8; ++k_) V[k_] = __builtin_nontemporal_load(src_ + k_ * 64); } } while (0)
#define CP_STORE(V, OK, UN) do { if (OK) { const int seg_ = (UN) / CPB, chn_ = (UN) % CPB, kv_ = seg_ >> 5, b_ = seg_ & 31; \
        f32x4* dst_ = (f32x4*)(p.out + (kv_ ? O_CVS : O_CKS) + (size_t)b_ * (2048 * 1536)) + chn_ * 512 + lane; \
        _Pragma("unroll") for (int k_ = 0; k_ < 8; ++k_) __builtin_nontemporal_store(V[k_], dst_ + k_ * 64); } } while (0)
    {
        constexpr int I_IN = (DM / 64) * (2 * FF / 32), I_OUT = (FF / 64) * (DM / 32), I_GLU = (DM / 64) * (2048 / 32), I_KV = (DM / 64) * (3072 / 32), I_Q = (DM / 64) * (1536 / 32), I_O = (512 / 64) * (1024 / 32);
        constexpr int NIT = 4 * I_IN + 4 * I_OUT + I_GLU + I_KV + I_Q + I_O;
        for (int it = gw; it < NIT; it += NGW) {
            f32x4 c0[8], c1[8]; bool k0, k1; const int u0 = cu, u1 = cu + NGW; cu += 2 * NGW;
            CP_ISSUE(c0, k0, u0); CP_ISSUE(c1, k1, u1);
            do {
            int r = it;
            if (r < 4 * I_IN) { const int w = r / I_IN, l = w & 1, which = w >> 1; r -= w * I_IN;
                const float* W = (which ? p.ffn_w2_in : p.ffn_w1_in) + (size_t)l * DM * 2 * FF; const float* g = (which ? p.ffn_norm2 : p.ffn_norm1) + l * DM;
                bf16_t* WT = (bf16_t*)(ws + (which ? WS_W2IN : WS_W1IN) + l * W_IN_B);
                wt_item(W, DM, 2 * FF, WT, g, FF, scr, r, lane); break; }
            r -= 4 * I_IN;
            if (r < 4 * I_OUT) { const int w = r / I_OUT, l = w & 1, which = w >> 1; r -= w * I_OUT;
                const float* W = (which ? p.ffn_w2_out : p.ffn_w1_out) + (size_t)l * FF * DM;
                bf16_t* WT = (bf16_t*)(ws + (which ? WS_W2OUT : WS_W1OUT) + l * W_OUT_B);
                wt_item(W, FF, DM, WT, nullptr, 0, scr, r, lane); break; }
            r -= 4 * I_OUT;
            if (r < I_GLU) { wt_item(p.w_glu, DM, 2048, (bf16_t*)(ws + WS_WGLU), nullptr, 1024, scr, r, lane); break; }
            r -= I_GLU;
            if (r < I_KV) { wt_item(p.w_kv, DM, 3072, (bf16_t*)(ws + WS_WKV), p.kv_norm, 0, scr, r, lane); break; }
            r -= I_KV;
            if (r < I_Q) { wt_item(p.w_q, DM, 1536, (bf16_t*)(ws + WS_WQ), p.mix_norm + DM, 0, scr, r, lane); break; }
            r -= I_Q;
            wt_item(p.w_o, 512, 1024, (bf16_t*)(ws + WS_WO), nullptr, 0, scr, r, lane);
            } while (0);
            CP_STORE(c0, k0, u0); CP_STORE(c1, k1, u1);
        }
    }
    {
        float* X = (float*)(ws + WS_X); bf16_t* Xb = (bf16_t*)(ws + WS_XB); float* ss0 = (float*)(ws + WS_SS);
        for (int row = gw; row < MT; row += NGW) {
            f32x4 c0[8]; bool k0; const int u0 = cu; cu += NGW; CP_ISSUE(c0, k0, u0);
            const float* src = row < T_P ? p.x_prompt + (size_t)row * DM : p.x_sample + (size_t)(row - T_P) * DM;
            float s = 0.f;
#pragma unroll
            for (int j = 0; j < 4; ++j) { const f32x4 v = ((const f32x4*)src)[lane + 64 * j]; ((f32x4*)(X + (size_t)row * DM))[lane + 64 * j] = v; s += (v.x * v.x + v.y * v.y) + (v.z * v.z + v.w * v.w);
                u32x2 o; o.x = cvt_pk_bf16(v.x, v.y); o.y = cvt_pk_bf16(v.z, v.w); ((u32x2*)(Xb + (size_t)row * DM))[lane + 64 * j] = o; }
            s = wave_sum(s); if (lane == 0) ss0[row] = s;
            CP_STORE(c0, k0, u0);
        }
    }
    { float* ss = (float*)(ws + WS_SS) + MT; for (size_t i = gt; i < (size_t)6 * MT; i += NT) ss[i] = 0.f; }
    {
        float* rope = (float*)(ws + WS_ROPE);
        for (size_t i = gt; i < (size_t)MT * 8; i += NT) { const int row = (int)(i >> 3), k = (int)(i & 7);
            const int posq = row < T_P ? (row & 8191) : 16384 + ((row - T_P) & 7);
            const double inv = exp(-(double)(2 * k) / 16.0 * 13.122363377404328);
            double s, c; dsincos((double)posq * inv, s, c); rope[i * 2] = (float)c; rope[i * 2 + 1] = (float)s; }
    }
    {
        float* LAM = (float*)(ws + WS_LAM); float* LAM64 = (float*)(ws + WS_LAM64); float* BRE = (float*)(ws + WS_BRE); float* BIM = (float*)(ws + WS_BIM); bf16_t* CPK = (bf16_t*)(ws + WS_CPK);
        for (size_t i = gt; i < 4096; i += NT) { const int g = (int)(i >> 6), pp = (int)(i & 63);
            const double dt = exp((double)p.log_dt[g]), are = p.a_re[i], aim = p.a_im[i];
            double s, c; dsincos(aim * dt, s, c); const double mag = exp(are * dt), lr = mag * c, li = mag * s;
            LAM[2 * i] = (float)lr; LAM[2 * i + 1] = (float)li;
            dsincos(64.0 * aim * dt, s, c); const double m64 = exp(64.0 * are * dt); LAM64[2 * i] = (float)(m64 * c); LAM64[2 * i + 1] = (float)(m64 * s);
            const double den = are * are + aim * aim, nr = lr - 1.0, ni = li;
            const double cr = (nr * are + ni * aim) / den, ci = (ni * are - nr * aim) / den;
#pragma unroll
            for (int h = 0; h < 16; ++h) { const double br = p.b_re[i * 16 + h], bi = p.b_im[i * 16 + h];
                BRE[i * 16 + h] = (float)(cr * br - ci * bi); BIM[i * 16 + h] = (float)(cr * bi + ci * br);
                CPK[((size_t)g * 16 + h) * 128 + pp] = f2bf(p.c_re[((size_t)g * 16 + h) * 64 + pp]); CPK[((size_t)g * 16 + h) * 128 + 64 + pp] = f2bf(-p.c_im[((size_t)g * 16 + h) * 64 + pp]); }
        }
    }
    {
        bf16_t* KPS = (bf16_t*)(ws + WS_KPS);
        const unsigned n = 32u * 2048u * 24u * 8u;
        for (unsigned i = (unsigned)gt; i < n; i += (unsigned)NT) { const int ch = (int)(i & 7); const unsigned hq = i >> 3; const int head = (int)(hq % 24u); const unsigned bp = hq / 24u; const int pos = (int)(bp & 2047), b = (int)(bp >> 11);
            const int br = head >> 3, sh = 2 * br;
            const bool need = br == 0 ? pos >= 1920 : br == 1 ? pos >= 1536 : (pos & 15) < 8;
            if (!need) continue;
            const int r = pos & ((1 << sh) - 1), m = pos >> sh, Lr = (2048 >> sh) + 8;
            const float* src = p.cache_k + (((size_t)b * 2048 + pos) * 24 + head) * 64 + ch * 8;
            const f32x4 a = *(const f32x4*)src, c = *(const f32x4*)(src + 4);
            u32x4 o; o.x = cvt_pk_bf16(a.x, a.y); o.y = cvt_pk_bf16(a.z, a.w); o.z = cvt_pk_bf16(c.x, c.y); o.w = cvt_pk_bf16(c.z, c.w);
            *(u32x4*)(KPS + (((size_t)b * 24 + head) * SROWS + r * Lr + m) * 64 + ch * 8) = o; }
    }
    {
        bf16_t* VTS = (bf16_t*)(ws + WS_VTS);
        LAS bf16_t* T = (LAS bf16_t*)scr;
        for (int it = gw; it < 32 * 208; it += NGW) { const int b = it / 208, rem = it % 208; int head, sub, r, m0;
            if (rem < 16) { head = rem >> 1; sub = rem & 1; r = 0; m0 = 1920 + 64 * sub; }
            else if (rem < 80) { const int x = rem - 16; head = 8 + (x >> 3); sub = x & 7; r = sub >> 1; m0 = 384 + 64 * (sub & 1); }
            else { const int x = rem - 80; head = 16 + (x >> 4); sub = x & 15; r = sub >> 1; m0 = 64 * (sub & 1); }
            const int sh = 2 * (head >> 3), Lr = (2048 >> sh) + 8;
            f32x4 c0[8], c1[8]; bool k0, k1; const int u0 = cu, u1 = cu + NGW; cu += 2 * NGW; CP_ISSUE(c0, k0, u0); CP_ISSUE(c1, k1, u1);
#pragma unroll
            for (int hh = 0; hh < 2; ++hh) { float tv[32];
#pragma unroll
                for (int mm = 0; mm < 32; ++mm) { const int pos = ((m0 + 32 * hh + mm) << sh) + r; tv[mm] = p.cache_v[(((size_t)b * 2048 + pos) * 24 + head) * 64 + lane]; }
#pragma unroll
                for (int mm = 0; mm < 32; ++mm) T[lane * 66 + 32 * hh + mm] = f2bf(tv[mm]); }
            LDS_FENCE();
            bf16_t* dst = VTS + ((size_t)b * 24 + head) * (64 * SROWS) + (size_t)r * 64 * Lr + m0;
#pragma unroll
            for (int j = 0; j < 8; ++j) { const int dd = 8 * j + (lane >> 3), ch = lane & 7; const LAS unsigned* s = (const LAS unsigned*)(T + dd * 66 + 8 * ch);
                u32x4 o; o.x = s[0]; o.y = s[1]; o.z = s[2]; o.w = s[3]; *(u32x4*)(dst + (size_t)dd * Lr + 8 * ch) = o; }
            LDS_FENCE();
            CP_STORE(c0, k0, u0); CP_STORE(c1, k1, u1);
        }
    }
    for (; cu < NCU; cu += NGW) { f32x4 c0[8]; bool k0; CP_ISSUE(c0, k0, cu); CP_STORE(c0, k0, cu); }
#undef CP_ISSUE
#undef CP_STORE
#undef NCU_LIM
}

struct EpiSwiGLU {
    static constexpr bool PERM = true, AFTER_DRAIN = false;
    bf16_t* H; const float* ss;
    __device__ __forceinline__ void operator()(const f32x4 (&acc)[2][2][4][2], const pg8::Unit& u, int wr, int wc, int fr, int fq) const {
        const int row0 = u.pm * 256 + wr * 64 + fr, col0 = u.pn * 128 + wc * 32 + 8 * fq;
#pragma unroll
        for (int ai = 0; ai < 2; ++ai)
#pragma unroll
            for (int m = 0; m < 4; ++m) { const int row = row0 + ai * 128 + m * 16; const float rs = rs_of(ss[row]);
                float h[8];
#pragma unroll
                for (int n = 0; n < 2; ++n)
#pragma unroll
                    for (int j = 0; j < 4; ++j) { const float g = acc[ai][0][m][n][j] * rs, uu = acc[ai][1][m][n][j] * rs; h[4 * n + j] = g * __builtin_amdgcn_rcpf(1.f + __expf(-g)) * uu; }
                u32x4 w; w.x = cvt_pk_bf16(h[0], h[1]); w.y = cvt_pk_bf16(h[2], h[3]); w.z = cvt_pk_bf16(h[4], h[5]); w.w = cvt_pk_bf16(h[6], h[7]);
                *(u32x4*)(H + (size_t)row * FF + col0) = w; }
    }
};
struct EpiResid {
    static constexpr bool PERM = true, AFTER_DRAIN = false;
    float* X; bf16_t* Xb; float* ss_out; float scale;
    __device__ __forceinline__ void operator()(const f32x4 (&acc)[2][2][4][2], const pg8::Unit& u, int wr, int wc, int fr, int fq) const {
        const int row0 = u.pm * 256 + wr * 64 + fr;
#pragma unroll
        for (int ai = 0; ai < 2; ++ai)
#pragma unroll
            for (int m = 0; m < 4; ++m) { const int row = row0 + ai * 128 + m * 16; float sq = 0.f;
#pragma unroll
                for (int bj = 0; bj < 2; ++bj) { const int col = u.pn * 256 + bj * 128 + wc * 32 + 8 * fq; float* xp = X + (size_t)row * DM + col;
                    f32x4 a = *(const f32x4*)xp, b = *(const f32x4*)(xp + 4); a += acc[ai][bj][m][0] * scale; b += acc[ai][bj][m][1] * scale;
                    *(f32x4*)xp = a; *(f32x4*)(xp + 4) = b; sq += (a.x * a.x + a.y * a.y) + (a.z * a.z + a.w * a.w) + (b.x * b.x + b.y * b.y) + (b.z * b.z + b.w * b.w);
                    u32x4 w; w.x = cvt_pk_bf16(a.x, a.y); w.y = cvt_pk_bf16(a.z, a.w); w.z = cvt_pk_bf16(b.x, b.y); w.w = cvt_pk_bf16(b.z, b.w);
                    *(u32x4*)(Xb + (size_t)row * DM + col) = w; }
                sq += __shfl_xor(sq, 16); sq += __shfl_xor(sq, 32);
                if (fq == 0) unsafeAtomicAdd(ss_out + row, sq); }
    }
};
struct EpiGLU {
    static constexpr bool PERM = true, AFTER_DRAIN = false;
    float* X; bf16_t* Xb; float* ss_out;
    __device__ __forceinline__ void operator()(const f32x4 (&acc)[2][2][4][2], const pg8::Unit& u, int wr, int wc, int fr, int fq) const {
        const int row0 = u.pm * 256 + wr * 64 + fr, col = u.pn * 128 + wc * 32 + 8 * fq;
#pragma unroll
        for (int ai = 0; ai < 2; ++ai)
#pragma unroll
            for (int m = 0; m < 4; ++m) { const int row = row0 + ai * 128 + m * 16; float* xp = X + (size_t)row * DM + col;
                f32x4 a = *(const f32x4*)xp, b = *(const f32x4*)(xp + 4);
#pragma unroll
                for (int j = 0; j < 4; ++j) { a[j] += acc[ai][0][m][0][j] * __builtin_amdgcn_rcpf(1.f + __expf(-acc[ai][1][m][0][j])); b[j] += acc[ai][0][m][1][j] * __builtin_amdgcn_rcpf(1.f + __expf(-acc[ai][1][m][1][j])); }
                *(f32x4*)xp = a; *(f32x4*)(xp + 4) = b;
                float sq = (a.x * a.x + a.y * a.y) + (a.z * a.z + a.w * a.w) + (b.x * b.x + b.y * b.y) + (b.z * b.z + b.w * b.w);
                u32x4 w; w.x = cvt_pk_bf16(a.x, a.y); w.y = cvt_pk_bf16(a.z, a.w); w.z = cvt_pk_bf16(b.x, b.y); w.w = cvt_pk_bf16(b.z, b.w);
                *(u32x4*)(Xb + (size_t)row * DM + col) = w;
                sq += __shfl_xor(sq, 16); sq += __shfl_xor(sq, 32);
                if (fq == 0) unsafeAtomicAdd(ss_out + row, sq); }
    }
};
__device__ __forceinline__ void rope8(f32x4& v0, f32x4& v1, const float* cs, bool rot_wave, int fq) {
    if (rot_wave) {
        const f32x4 c01 = *(const f32x4*)cs, c23 = *(const f32x4*)(cs + 4), c45 = *(const f32x4*)(cs + 8), c67 = *(const f32x4*)(cs + 12);
        const float cc[8] = {c01.x, c01.z, c23.x, c23.z, c45.x, c45.z, c67.x, c67.z}, sn[8] = {c01.y, c01.w, c23.y, c23.w, c45.y, c45.w, c67.y, c67.w};
#pragma unroll
        for (int j = 0; j < 4; ++j) {
            const float p0 = __shfl_xor(v0[j], 16), p1 = __shfl_xor(v1[j], 16);
            const float a0 = fq == 0 ? v0[j] * cc[j] - p0 * sn[j] : v0[j] * cc[j] + p0 * sn[j];
            const float a1 = fq == 0 ? v1[j] * cc[4 + j] - p1 * sn[4 + j] : v1[j] * cc[4 + j] + p1 * sn[4 + j];
            if (fq < 2) { v0[j] = a0; v1[j] = a1; }
        }
    }
}
struct EpiKV {
    static constexpr bool PERM = true, AFTER_DRAIN = false;
    const float* ss; const float* rope; float* out; bf16_t *KPP, *VTP, *KPS, *VTS;
    __device__ __forceinline__ void operator()(const f32x4 (&acc)[2][2][4][2], const pg8::Unit& u, int wr, int wc, int fr, int fq) const {
        const int row0 = u.pm * 256 + wr * 64 + fr; const bool isv = u.pn >= 6; const int pn6 = isv ? u.pn - 6 : u.pn;
        const int dim0 = 32 * (wc & 1) + 8 * fq; const bool rot_wave = !isv && (wc & 1) == 0;
#pragma unroll
        for (int ai = 0; ai < 2; ++ai)
#pragma unroll
            for (int m = 0; m < 4; ++m) { const int row = row0 + ai * 128 + m * 16; const float rs = rs_of(ss[row]);
                int is_s, b, pos; tok_info(row, is_s, b, pos);
#pragma unroll
                for (int bj = 0; bj < 2; ++bj) { const int head = pn6 * 4 + 2 * bj + (wc >> 1), sh = 2 * (head >> 3);
                    f32x4 v0 = acc[ai][bj][m][0] * rs, v1 = acc[ai][bj][m][1] * rs;
                    rope8(v0, v1, rope + (size_t)row * 16, rot_wave, fq);
                    if (is_s) { float* o = out + (isv ? O_CVS : O_CKS) + (((size_t)b * 2048 + (pos - 8)) * 24 + head) * 64 + dim0; *(f32x4*)o = v0; *(f32x4*)(o + 4) = v1; }
                    else if (pos >= 6144) { float* o = out + (isv ? O_CVP : O_CKP) + (((size_t)b * 2048 + (pos - 6144)) * 24 + head) * 64 + dim0; *(f32x4*)o = v0; *(f32x4*)(o + 4) = v1; }
                    const int r = pos & ((1 << sh) - 1), mm = pos >> sh, Lr = is_s ? (2048 >> sh) + 8 : (8192 >> sh);
                    if (!isv) { u32x4 w; w.x = cvt_pk_bf16(v0.x, v0.y); w.y = cvt_pk_bf16(v0.z, v0.w); w.z = cvt_pk_bf16(v1.x, v1.y); w.w = cvt_pk_bf16(v1.z, v1.w);
                        bf16_t* kb = is_s ? KPS + ((size_t)b * 24 + head) * SROWS * 64 : KPP + ((size_t)b * 24 + head) * 8192 * 64;
                        *(u32x4*)(kb + ((size_t)r * Lr + mm) * 64 + dim0) = w; }
                    else { bf16_t* vb = (is_s ? VTS + ((size_t)b * 24 + head) * (64 * SROWS) : VTP + ((size_t)b * 24 + head) * (64 * 8192)) + ((size_t)r * 64 + dim0) * Lr + mm;
#pragma unroll
                        for (int j = 0; j < 4; ++j) { vb[(size_t)j * Lr] = f2bf(v0[j]); vb[(size_t)(4 + j) * Lr] = f2bf(v1[j]); } }
                }
            }
    }
};
struct EpiQ {
    static constexpr bool PERM = true, AFTER_DRAIN = false;
    const float* ss; const float* rope; bf16_t *QP, *QS;
    __device__ __forceinline__ void operator()(const f32x4 (&acc)[2][2][4][2], const pg8::Unit& u, int wr, int wc, int fr, int fq) const {
        const int row0 = u.pm * 256 + wr * 64 + fr; const int dim0 = 32 * (wc & 1) + 8 * fq; const bool rot_wave = (wc & 1) == 0;
#pragma unroll
        for (int ai = 0; ai < 2; ++ai)
#pragma unroll
            for (int m = 0; m < 4; ++m) { const int row = row0 + ai * 128 + m * 16; const float rs = rs_of(ss[row]);
                int is_s, b, pos; tok_info(row, is_s, b, pos);
#pragma unroll
                for (int bj = 0; bj < 2; ++bj) { const int head = u.pn * 4 + 2 * bj + (wc >> 1), sh = 2 * (head >> 3);
                    f32x4 v0 = acc[ai][bj][m][0] * rs, v1 = acc[ai][bj][m][1] * rs;
                    rope8(v0, v1, rope + (size_t)row * 16, rot_wave, fq);
                    v0 *= 0.125f; v1 *= 0.125f;
                    u32x4 w; w.x = cvt_pk_bf16(v0.x, v0.y); w.y = cvt_pk_bf16(v0.z, v0.w); w.z = cvt_pk_bf16(v1.x, v1.y); w.w = cvt_pk_bf16(v1.z, v1.w);
                    const int r = pos & ((1 << sh) - 1), mm = pos >> sh;
                    if (is_s) { const int j = pos - 2048; const int qidx = sh == 0 ? j : sh == 2 ? (j & 3) * 2 + (j >> 2) : j;
                        *(u32x4*)(QS + (((size_t)b * 24 + head) * 8 + qidx) * 64 + dim0) = w; }
                    else *(u32x4*)(QP + (((size_t)b * 24 + head) * 8192 + (size_t)r * (8192 >> sh) + mm) * 64 + dim0) = w;
                }
            }
    }
};

template <class Epi>
__device__ __forceinline__ void run_gemm(LAS unsigned char* lds, const bf16_t* A, const bf16_t* Bt, int N, int K, const Epi& E) {
    pg8::Gemm g; g.A = A; g.Bt = Bt; g.M = MT; g.N = N; g.K = K;
    pg8::StaticOrder S; S.init(MT, N, (int)gridDim.x, (int)blockIdx.x);
    pg8::gemm_phase<Epi, pg8::StaticOrder, false>(lds, g, S, E, nullptr);
}

template <bool FULL>
__device__ __forceinline__ void s5_pass(const Params& p, LAS unsigned char* lds) {
    const int tid = tid_opaque(), lane = tid & 63, wave = tid >> 6, fr = lane & 15, fq = lane >> 4;
    unsigned char* ws = p.ws;
    const float* X = (const float*)(ws + WS_X); const float* ss1 = (const float*)(ws + WS_SS) + MT;
    const float* LAM = (const float*)(ws + WS_LAM); const float* LAM64 = (const float*)(ws + WS_LAM64); const float* BRE = (const float*)(ws + WS_BRE); const float* BIM = (const float*)(ws + WS_BIM);
    const bf16_t* CPK = (const bf16_t*)(ws + WS_CPK); float* SLOC = (float*)(ws + WS_SLOC); bf16_t* Z = (bf16_t*)(ws + WS_Z);
    LAS float* U = (LAS float*)lds;
    LAS bf16_t* Hs = (LAS bf16_t*)(lds + 32768) + wave * (16 * 136);
    const int nitems = FULL ? 2304 : 2048;
    float Bre[16], Bim[16]; float lr = 0.f, li = 0.f, l6r = 0.f, l6i = 0.f, dsk = 0.f; bf16x8 cf[4];
#pragma unroll
    for (int q = 0; q < 16; ++q) { Bre[q] = 0.f; Bim[q] = 0.f; }
#pragma unroll
    for (int kk = 0; kk < 4; ++kk) cf[kk] = (bf16x8){0, 0, 0, 0, 0, 0, 0, 0};
    int go_ld = -1, car_b = -1, car_c = 0; float car_r = 0.f, car_i = 0.f;
    for (int it = blockIdx.x; it < nitems; it += gridDim.x) {
        f32x4 cpv[8]; const int cun = NCU0 + (FULL ? NCU_S5A : 0) + it * 8 + wave;
        { const int seg_ = cun / CPB, chn_ = cun % CPB, kv_ = seg_ >> 5, b_ = seg_ & 31;
          const f32x4* src_ = (const f32x4*)((kv_ ? p.cache_v : p.cache_k) + (size_t)b_ * (2048 * 1536) + 8 * 1536) + chn_ * 512 + lane;
#pragma unroll
          for (int k_ = 0; k_ < 8; ++k_) cpv[k_] = __builtin_nontemporal_load(src_ + k_ * 64); }
        int is_s, b, c, go, tok0, nt;
        if (it < 2048) { is_s = 0; b = it >> 10; c = (it >> 3) & 127; go = it & 7; tok0 = b * 8192 + c * 64; nt = 64; }
        else { const int x = it - 2048; is_s = 1; b = x >> 3; go = x & 7; c = 0; tok0 = T_P + b * 8; nt = 8; }
        for (int i = tid; i < nt * 32; i += NTHREADS) { const int t = i >> 5, c4 = i & 31, row = tok0 + t; const float rs = rs_of(ss1[row]);
            f32x4 v = *(const f32x4*)(X + (size_t)row * DM + go * 128 + c4 * 4); const f32x4 gg = *(const f32x4*)(p.mix_norm + go * 128 + c4 * 4);
            v = v * rs * gg; *(LAS f32x4*)(U + t * 128 + c4 * 4) = v; }
        __syncthreads();
        const int g = go * 8 + wave, gp = g * 64 + lane;
        if (go != go_ld) {
            go_ld = go; car_b = -1;
#pragma unroll
            for (int q = 0; q < 4; ++q) { const f32x4 a = *(const f32x4*)(BRE + (size_t)gp * 16 + 4 * q), bb = *(const f32x4*)(BIM + (size_t)gp * 16 + 4 * q);
#pragma unroll
                for (int j = 0; j < 4; ++j) { Bre[4 * q + j] = a[j]; Bim[4 * q + j] = bb[j]; } }
            lr = LAM[2 * gp]; li = LAM[2 * gp + 1];
            if (FULL) { l6r = LAM64[2 * gp]; l6i = LAM64[2 * gp + 1];
#pragma unroll
                for (int kk = 0; kk < 4; ++kk) cf[kk] = *(const bf16x8*)(CPK + ((size_t)g * 16 + fr) * 128 + 32 * kk + 8 * fq);
                dsk = p.ssm_d[16 * g + fr]; }
        }
        float hre = 0.f, him = 0.f;
        if (FULL) {
            if (is_s) { const float* s0 = p.state_ssm + ((size_t)b * 4096 + gp) * 2; hre = s0[0]; him = s0[1]; }
            else {
                typedef float f32x2 __attribute__((ext_vector_type(2)));
                if (b != car_b || c < car_c) { car_b = b; car_c = 0; car_r = 0.f; car_i = 0.f; }
                for (int j0 = car_c; j0 < c; j0 += 16) { f32x2 sv[16];
#pragma unroll
                    for (int k = 0; k < 16; ++k) { const int j = (j0 + k < c) ? j0 + k : c - 1; sv[k] = *(const f32x2*)(SLOC + (((size_t)b * 128 + j) * 4096 + gp) * 2); }
#pragma unroll
                    for (int k = 0; k < 16; ++k) if (j0 + k < c) { const float nr = l6r * car_r - l6i * car_i + sv[k].x; car_i = l6r * car_i + l6i * car_r + sv[k].y; car_r = nr; } }
                car_c = c; hre = car_r; him = car_i; }
        }
        for (int t0 = 0; t0 < nt; t0 += 16) {
#pragma unroll 4
            for (int tt = 0; tt < 16; ++tt) {
                if (t0 + tt < nt) {
                    const LAS float* ur = U + (t0 + tt) * 128 + 16 * wave;
                    float bre = 0.f, bim = 0.f;
#pragma unroll
                    for (int q = 0; q < 4; ++q) { const f32x4 uv = *(const LAS f32x4*)(ur + 4 * q);
#pragma unroll
                        for (int j = 0; j < 4; ++j) { bre = fmaf(Bre[4 * q + j], uv[j], bre); bim = fmaf(Bim[4 * q + j], uv[j], bim); } }
                    const float nr = lr * hre - li * him + bre; him = lr * him + li * hre + bim; hre = nr;
                }
                if (FULL) { Hs[tt * 136 + lane] = f2bf(hre); Hs[tt * 136 + 64 + lane] = f2bf(him); }
            }
            if (FULL) {
                LDS_FENCE();
                f32x4 y = {0.f, 0.f, 0.f, 0.f};
#pragma unroll
                for (int kk = 0; kk < 4; ++kk) { const bf16x8 af = *(const LAS bf16x8*)(Hs + fr * 136 + 32 * kk + 8 * fq); y = __builtin_amdgcn_mfma_f32_16x16x32_bf16(af, cf[kk], y, 0, 0, 0); }
#pragma unroll
                for (int e = 0; e < 4; ++e) { const int t = t0 + 4 * fq + e;
                    if (t < nt) { const float yy = y[e] + dsk * U[t * 128 + 16 * wave + fr];
                        const float a = 0.7978845608028654f * (yy + 0.044715f * yy * yy * yy); const float th = 1.f - 2.f * __builtin_amdgcn_rcpf(__expf(2.f * a) + 1.f);
                        Z[(size_t)(tok0 + t) * DM + 16 * g + fr] = f2bf(0.5f * yy * (1.f + th)); } }
                LDS_FENCE();
            }
        }
        if (FULL) {
            if (is_s) { float* o = p.out + O_SSS + ((size_t)b * 4096 + gp) * 2; o[0] = hre; o[1] = him; }
            else if (c == 127) { float* o = p.out + O_SSP + ((size_t)b * 4096 + gp) * 2; o[0] = hre; o[1] = him; }
        } else { float* s = SLOC + (((size_t)b * 128 + c) * 4096 + gp) * 2; s[0] = hre; s[1] = him; }
        { const int seg_ = cun / CPB, chn_ = cun % CPB, kv_ = seg_ >> 5, b_ = seg_ & 31;
          f32x4* dst_ = (f32x4*)(p.out + (kv_ ? O_CVS : O_CKS) + (size_t)b_ * (2048 * 1536)) + chn_ * 512 + lane;
#pragma unroll
          for (int k_ = 0; k_ < 8; ++k_) __builtin_nontemporal_store(cpv[k_], dst_ + k_ * 64); }
        __syncthreads();
    }
}

__device__ __forceinline__ void attn_phase(const Params& p) {
    const int tid = tid_opaque(), lane = tid & 63, wave = tid >> 6, fr = lane & 15, fq = lane >> 4;
    const int gw = blockIdx.x * NWAVES + wave, NGW = gridDim.x * NWAVES;
    unsigned char* ws = p.ws;
    const bf16_t *QP = (const bf16_t*)(ws + WS_QP), *QS = (const bf16_t*)(ws + WS_QS), *KPP = (const bf16_t*)(ws + WS_KPP), *VTP = (const bf16_t*)(ws + WS_VTP), *KPS = (const bf16_t*)(ws + WS_KPS), *VTS = (const bf16_t*)(ws + WS_VTS);
    float* OBR = (float*)(ws + WS_OBR); float* LSE = (float*)(ws + WS_LSE);
    constexpr int NP = 2 * 24 * 512, NS = 32 * 104;
    for (int item = gw; item < NP + NS; item += NGW) {
        int is_s, b, head, r, mq0, nqv;
        if (item < NP) { is_s = 0; b = item / 12288; const int rem = item % 12288; head = rem >> 9; const int wt = rem & 511; const int sh = 2 * (head >> 3), per = 512 >> sh; r = wt / per; mq0 = 16 * (wt % per); nqv = 16; }
        else { const int si = item - NP; is_s = 1; b = si / 104; const int rem = si % 104;
            if (rem < 8) { head = rem; r = 0; mq0 = 2048; nqv = 8; }
            else if (rem < 40) { const int x = rem - 8; head = 8 + (x >> 2); r = x & 3; mq0 = 512; nqv = 2; }
            else { const int x = rem - 40; head = 16 + (x >> 3); r = x & 7; mq0 = 128; nqv = 1; } }
        const int sh = 2 * (head >> 3);
        const int Lr = is_s ? (2048 >> sh) + 8 : (8192 >> sh);
        const bf16_t* Kb = (is_s ? KPS + ((size_t)b * 24 + head) * SROWS * 64 : KPP + ((size_t)b * 24 + head) * 8192 * 64) + (size_t)r * Lr * 64;
        const bf16_t* Vb = (is_s ? VTS + ((size_t)b * 24 + head) * (64 * SROWS) : VTP + ((size_t)b * 24 + head) * (64 * 8192)) + (size_t)r * 64 * Lr;
        const int qi = fr < nqv ? fr : nqv - 1;
        const bf16_t* Qrow = is_s ? QS + (((size_t)b * 24 + head) * 8 + r * nqv + qi) * 64 : QP + (((size_t)b * 24 + head) * 8192 + (size_t)r * Lr + mq0 + qi) * 64;
        const bf16x8 q0 = *(const bf16x8*)(Qrow + 8 * fq), q1 = *(const bf16x8*)(Qrow + 32 + 8 * fq);
        const int mk0 = mq0 - 128;
        f32x4 s[9];
#pragma unroll
        for (int blk = 0; blk < 9; ++blk) { int mj = mk0 + 16 * blk + fr; mj = mj < 0 ? 0 : (mj > Lr - 1 ? Lr - 1 : mj);
            const bf16_t* kr = Kb + (size_t)mj * 64 + 8 * fq; const bf16x8 k0 = *(const bf16x8*)kr, k1 = *(const bf16x8*)(kr + 32);
            f32x4 a = {0.f, 0.f, 0.f, 0.f}; a = __builtin_amdgcn_mfma_f32_16x16x32_bf16(k0, q0, a, 0, 0, 0); s[blk] = __builtin_amdgcn_mfma_f32_16x16x32_bf16(k1, q1, a, 0, 0, 0); }
        float mx = -3.0e38f;
#pragma unroll
        for (int blk = 0; blk < 9; ++blk)
#pragma unroll
            for (int e = 0; e < 4; ++e) { const int j = 16 * blk + 4 * fq + e; const bool ok = (j >= fr) && (j <= fr + 128) && (mk0 + j >= 0);
                const float v = ok ? s[blk][e] : -1.0e30f; s[blk][e] = v; mx = fmaxf(mx, v); }
        mx = fmaxf(mx, __shfl_xor(mx, 16)); mx = fmaxf(mx, __shfl_xor(mx, 32));
        float l = 0.f;
#pragma unroll
        for (int blk = 0; blk < 9; ++blk)
#pragma unroll
            for (int e = 0; e < 4; ++e) { const float pe = __expf(s[blk][e] - mx); l += pe; s[blk][e] = pe; }
        l += __shfl_xor(l, 16); l += __shfl_xor(l, 32);
        f32x4 o[4];
#pragma unroll
        for (int db = 0; db < 4; ++db) o[db] = (f32x4){0.f, 0.f, 0.f, 0.f};
#pragma unroll
        for (int pr = 0; pr < 5; ++pr) {
            u32x4 pw; pw.x = cvt_pk_bf16(s[2 * pr][0], s[2 * pr][1]); pw.y = cvt_pk_bf16(s[2 * pr][2], s[2 * pr][3]);
            if (pr < 4) { pw.z = cvt_pk_bf16(s[2 * pr + 1][0], s[2 * pr + 1][1]); pw.w = cvt_pk_bf16(s[2 * pr + 1][2], s[2 * pr + 1][3]); } else { pw.z = 0u; pw.w = 0u; }
            const bf16x8 pf = __builtin_bit_cast(bf16x8, pw);
            int ma = mk0 + 32 * pr + 4 * fq, mb = ma + 16;
            ma = ma < 0 ? 0 : (ma > Lr - 4 ? Lr - 4 : ma); mb = mb < 0 ? 0 : (mb > Lr - 4 ? Lr - 4 : mb);
#pragma unroll
            for (int db = 0; db < 4; ++db) { const bf16_t* vr = Vb + (size_t)(16 * db + fr) * Lr;
                const u32x2 va = *(const u32x2*)(vr + ma), vb = *(const u32x2*)(vr + mb);
                u32x4 vw; vw.x = va.x; vw.y = va.y; vw.z = vb.x; vw.w = vb.y;
                o[db] = __builtin_amdgcn_mfma_f32_16x16x32_bf16(__builtin_bit_cast(bf16x8, vw), pf, o[db], 0, 0, 0); }
        }
        if (fr < nqv) {
            const int pq = ((mq0 + fr) << sh) + r;
            const int token = is_s ? T_P + b * 8 + (pq - 2048) : b * 8192 + pq;
            const float inv = 1.f / l;
#pragma unroll
            for (int db = 0; db < 4; ++db) *(f32x4*)(OBR + (size_t)token * AW + head * 64 + 16 * db + 4 * fq) = o[db] * inv;
            if (fq == 0) LSE[(size_t)token * 24 + head] = mx + logf(l);
        }
    }
}

__device__ __forceinline__ void merge_phase(const Params& p) {
    const size_t gt = (size_t)blockIdx.x * NTHREADS + tid_opaque(), NT = (size_t)gridDim.x * NTHREADS;
    const float* OBR = (const float*)(p.ws + WS_OBR); const float* LSE = (const float*)(p.ws + WS_LSE); bf16_t* OB = (bf16_t*)(p.ws + WS_OB);
    for (size_t i = gt; i < (size_t)MT * 64; i += NT) { const size_t token = i >> 6; const int h = (int)((i >> 3) & 7), ch = (int)(i & 7);
        const float l0 = LSE[token * 24 + h], l1 = LSE[token * 24 + 8 + h], l2 = LSE[token * 24 + 16 + h];
        const float mx = fmaxf(l0, fmaxf(l1, l2)); float w0 = __expf(l0 - mx), w1 = __expf(l1 - mx), w2 = __expf(l2 - mx); const float inv = 1.f / (w0 + w1 + w2); w0 *= inv; w1 *= inv; w2 *= inv;
        const float* o0 = OBR + token * AW + h * 64 + ch * 8;
        const f32x4 a0 = *(const f32x4*)o0, b0 = *(const f32x4*)(o0 + 4), a1 = *(const f32x4*)(o0 + 512), b1 = *(const f32x4*)(o0 + 516), a2 = *(const f32x4*)(o0 + 1024), b2 = *(const f32x4*)(o0 + 1028);
        const f32x4 a = a0 * w0 + a1 * w1 + a2 * w2, bb = b0 * w0 + b1 * w1 + b2 * w2;
        u32x4 w; w.x = cvt_pk_bf16(a.x, a.y); w.y = cvt_pk_bf16(a.z, a.w); w.z = cvt_pk_bf16(bb.x, bb.y); w.w = cvt_pk_bf16(bb.z, bb.w);
        *(u32x4*)(OB + token * MW + h * 64 + ch * 8) = w; }
}

__device__ __forceinline__ void final_phase(const Params& p) {
    const int lane = tid_opaque() & 63, wave = tid_opaque() >> 6;
    const int gw = blockIdx.x * NWAVES + wave, NGW = gridDim.x * NWAVES;
    const float* X = (const float*)(p.ws + WS_X); const float* ss6 = (const float*)(p.ws + WS_SS) + (size_t)6 * MT;
    for (int row = gw; row < MT; row += NGW) { const float rs = rs_of(ss6[row]);
        float* dst = row < T_P ? p.out + O_YP + (size_t)row * DM : p.out + O_YS + (size_t)(row - T_P) * DM;
#pragma unroll
        for (int j = 0; j < 4; ++j) { const f32x4 v = ((const f32x4*)(X + (size_t)row * DM))[lane + 64 * j], g = ((const f32x4*)p.final_norm)[lane + 64 * j]; ((f32x4*)dst)[lane + 64 * j] = v * rs * g; }
    }
}


__device__ __forceinline__ void ctr_barrier(unsigned* cnt, unsigned target) {
    asm volatile("s_waitcnt vmcnt(0)" ::: "memory");
    __syncthreads();
    if (threadIdx.x == 0) {
        __builtin_amdgcn_fence(__ATOMIC_RELEASE, "agent");
        asm volatile("s_waitcnt vmcnt(0)" ::: "memory");
        const unsigned k = target / gridDim.x;
        const unsigned old = __hip_atomic_fetch_add(cnt, 1u, __ATOMIC_RELAXED, __HIP_MEMORY_SCOPE_AGENT);
        if (old + 1u == target) __hip_atomic_store(cnt + 64, k, __ATOMIC_RELAXED, __HIP_MEMORY_SCOPE_AGENT);
        else { unsigned sp = 0; while (__hip_atomic_load(cnt + 64, __ATOMIC_RELAXED, __HIP_MEMORY_SCOPE_AGENT) < k) { __builtin_amdgcn_s_sleep(1); if (++sp > (1u << 24)) break; } }
        __builtin_amdgcn_fence(__ATOMIC_ACQUIRE, "agent");
        asm volatile("s_waitcnt vmcnt(0)" ::: "memory");
    }
    __syncthreads();
}
__global__ void __launch_bounds__(NTHREADS, 2) yoco_fwd(Params p) {
    extern __shared__ __attribute__((aligned(16))) unsigned char shm[];
    LAS unsigned char* lds = (LAS unsigned char*)shm;
    cg::grid_group grid = cg::this_grid();
    unsigned char* ws = p.ws;
    float* X = (float*)(ws + WS_X); bf16_t* Xb = (bf16_t*)(ws + WS_XB); bf16_t* H = (bf16_t*)(ws + WS_H); bf16_t* Z = (bf16_t*)(ws + WS_Z); float* SS = (float*)(ws + WS_SS);
    const float* rope = (const float*)(ws + WS_ROPE);

    phase0(p, lds);
    grid.sync();
    unsigned* gbar = (unsigned*)(ws + WS_BAR);
    { EpiSwiGLU e; e.H = H; e.ss = SS; run_gemm(lds, Xb, (const bf16_t*)(ws + WS_W1IN), 2 * FF, DM, e); }
    ctr_barrier(gbar, 1u * gridDim.x);
    { EpiResid e; e.X = X; e.Xb = Xb; e.ss_out = SS + MT; e.scale = 0.5f; run_gemm(lds, H, (const bf16_t*)(ws + WS_W1OUT), DM, FF, e); }
    ctr_barrier(gbar, 2u * gridDim.x);
    s5_pass<false>(p, lds);
    ctr_barrier(gbar, 3u * gridDim.x);
    s5_pass<true>(p, lds);
    ctr_barrier(gbar, 4u * gridDim.x);
    { EpiGLU e; e.X = X; e.Xb = Xb; e.ss_out = SS + 2 * MT; run_gemm(lds, Z, (const bf16_t*)(ws + WS_WGLU), 2048, DM, e); }
    ctr_barrier(gbar, 5u * gridDim.x);
    { EpiSwiGLU e; e.H = H; e.ss = SS + 2 * MT; run_gemm(lds, Xb, (const bf16_t*)(ws + WS_W2IN), 2 * FF, DM, e); }
    ctr_barrier(gbar, 6u * gridDim.x);
    { EpiResid e; e.X = X; e.Xb = Xb; e.ss_out = SS + 3 * MT; e.scale = 0.5f; run_gemm(lds, H, (const bf16_t*)(ws + WS_W2OUT), DM, FF, e); }
    ctr_barrier(gbar, 7u * gridDim.x);
    { EpiKV e; e.ss = SS + 3 * MT; e.rope = rope; e.out = p.out; e.KPP = (bf16_t*)(ws + WS_KPP); e.VTP = (bf16_t*)(ws + WS_VTP); e.KPS = (bf16_t*)(ws + WS_KPS); e.VTS = (bf16_t*)(ws + WS_VTS);
      run_gemm(lds, Xb, (const bf16_t*)(ws + WS_WKV), 3072, DM, e); }
    { EpiSwiGLU e; e.H = H; e.ss = SS + 3 * MT; run_gemm(lds, Xb, (const bf16_t*)(ws + WS_W1IN + W_IN_B), 2 * FF, DM, e); }
    ctr_barrier(gbar, 8u * gridDim.x);
    { EpiResid e; e.X = X; e.Xb = Xb; e.ss_out = SS + 4 * MT; e.scale = 0.5f; run_gemm(lds, H, (const bf16_t*)(ws + WS_W1OUT + W_OUT_B), DM, FF, e); }
    ctr_barrier(gbar, 9u * gridDim.x);
    { EpiQ e; e.ss = SS + 4 * MT; e.rope = rope; e.QP = (bf16_t*)(ws + WS_QP); e.QS = (bf16_t*)(ws + WS_QS); run_gemm(lds, Xb, (const bf16_t*)(ws + WS_WQ), 1536, DM, e); }
    ctr_barrier(gbar, 10u * gridDim.x);
    attn_phase(p);
    ctr_barrier(gbar, 11u * gridDim.x);
    merge_phase(p);
    ctr_barrier(gbar, 12u * gridDim.x);
    { EpiResid e; e.X = X; e.Xb = Xb; e.ss_out = SS + 5 * MT; e.scale = 1.0f; run_gemm(lds, (const bf16_t*)(ws + WS_OB), (const bf16_t*)(ws + WS_WO), DM, MW, e); }
    ctr_barrier(gbar, 13u * gridDim.x);
    { EpiSwiGLU e; e.H = H; e.ss = SS + 5 * MT; run_gemm(lds, Xb, (const bf16_t*)(ws + WS_W2IN + W_IN_B), 2 * FF, DM, e); }
    ctr_barrier(gbar, 14u * gridDim.x);
    { EpiResid e; e.X = X; e.Xb = Xb; e.ss_out = SS + 6 * MT; e.scale = 0.5f; run_gemm(lds, H, (const bf16_t*)(ws + WS_W2OUT + W_OUT_B), DM, FF, e); }
    ctr_barrier(gbar, 15u * gridDim.x);
    final_phase(p);
}

extern "C" void kernel_launch(void* const* d_in, const int* in_sizes, int n_in, void* d_out, int out_size, void* d_ws, size_t ws_size, hipStream_t stream) {
    static int grid_blocks = 0;
    if (grid_blocks == 0) {
        if (n_in != 26 || (size_t)out_size != O_END || ws_size < WS_END) { fprintf(stderr, "kernel_launch: unexpected shapes (n_in %d, out %d, ws %zu; need ws >= %zu)\n", n_in, out_size, ws_size, (size_t)WS_END); grid_blocks = -1; return; }
        int dev = 0, cus = 0, per_cu = 0;
        hipGetDevice(&dev);
        hipDeviceGetAttribute(&cus, hipDeviceAttributeMultiprocessorCount, dev);
        if (hipFuncSetAttribute((const void*)yoco_fwd, hipFuncAttributeMaxDynamicSharedMemorySize, LDS_BYTES) != hipSuccess) { fprintf(stderr, "kernel_launch: hipFuncSetAttribute failed\n"); grid_blocks = -1; return; }
        if (hipOccupancyMaxActiveBlocksPerMultiprocessor(&per_cu, (const void*)yoco_fwd, NTHREADS, LDS_BYTES) != hipSuccess || per_cu < 1) { fprintf(stderr, "kernel_launch: occupancy query failed (%d)\n", per_cu); per_cu = 1; (void)hipGetLastError(); }
        if (per_cu > 1) per_cu = 1;
        grid_blocks = cus * per_cu;
    }
    if (grid_blocks < 0) return;
    Params p{};
    const float** f = (const float**)&p;
    for (int i = 0; i < 26; ++i) f[i] = (const float*)d_in[i];
    p.out = (float*)d_out; p.ws = (unsigned char*)d_ws;
    void* args[] = {&p};
    (void)hipMemsetAsync((unsigned char*)d_ws + WS_BAR, 0, 512, stream);
    hipError_t e = hipLaunchCooperativeKernel((const void*)yoco_fwd, dim3(grid_blocks), dim3(NTHREADS), args, LDS_BYTES, stream);
    if (e != hipSuccess) fprintf(stderr, "cooperative launch failed: %s (grid %d)\n", hipGetErrorString(e), grid_blocks);
}
```
